# Optimizing an MI355X kernel written in HIP

```python
import math
import jax, jax.numpy as jnp
from jax import lax
import numpy as np

D_MODEL = 1024
BATCH = 4
SEQ = 8192
DEPTH = 1

SSM_WIDTH = D_MODEL // 2
SSM_GROUP = 16
SSM_GROUPS = SSM_WIDTH // SSM_GROUP
SSM_STATE = 64
DT_MIN = 1e-3
DT_MAX = 1e-1
ATTN_HEADS = 8
HEAD_DIM = 64
ATTN_WIDTH = ATTN_HEADS * HEAD_DIM
MOBA_BLOCK = 256
MOBA_TOPK = 3
Q_CHUNK = 32
N_BRANCH = 2
IN_WIDTH = SSM_WIDTH + 3 * ATTN_WIDTH + N_BRANCH * D_MODEL
D_FF = -(-8 * D_MODEL // (3 * 256)) * 256
N_MOD = 6
NORM_EPS = 1e-6

kernel_name = "hybrid_s5_moba_gated_sandwich_adaln"


def rms_norm(x, g):
    xf = x.astype(jnp.float32)
    y = xf * lax.rsqrt(jnp.mean(xf * xf, axis=-1, keepdims=True) + NORM_EPS)
    return (y * g.astype(jnp.float32)).astype(x.dtype)


def alibi_slopes(n_heads):
    return jnp.asarray(2.0 ** (-8.0 * np.arange(1, n_heads + 1) / n_heads), jnp.float32)


def s5_ssm(u, a_re, a_im, log_dt, b_re, b_im, c_re, c_im, d_skip):
    bsz, s, _ = u.shape
    f32 = jnp.float32
    uf = u.astype(f32).reshape(bsz, s, SSM_GROUPS, SSM_GROUP)
    a_re = a_re.astype(f32); a_im = a_im.astype(f32)
    dt = jnp.exp(log_dt.astype(f32))[:, None]
    mag = jnp.exp(dt * a_re)
    ab_re = mag * jnp.cos(dt * a_im)
    ab_im = mag * jnp.sin(dt * a_im)
    den = a_re * a_re + a_im * a_im
    nr = ab_re - 1.0
    co_re = (nr * a_re + ab_im * a_im) / den
    co_im = (ab_im * a_re - nr * a_im) / den
    b_re = b_re.astype(f32); b_im = b_im.astype(f32)
    bb_re = co_re[..., None] * b_re - co_im[..., None] * b_im
    bb_im = co_re[..., None] * b_im + co_im[..., None] * b_re
    bu_re = jnp.einsum('bsgc,gpc->sbgp', uf, bb_re)
    bu_im = jnp.einsum('bsgc,gpc->sbgp', uf, bb_im)
    a_seq_re = jnp.broadcast_to(ab_re[None, None], (s, 1) + ab_re.shape)
    a_seq_im = jnp.broadcast_to(ab_im[None, None], (s, 1) + ab_im.shape)

    def combine(left, right):
        ar_l, ai_l, br_l, bi_l = left
        ar_r, ai_r, br_r, bi_r = right
        ar = ar_r * ar_l - ai_r * ai_l
        ai = ar_r * ai_l + ai_r * ar_l
        br = ar_r * br_l - ai_r * bi_l + br_r
        bi = ar_r * bi_l + ai_r * br_l + bi_r
        return (ar, ai, br, bi)

    _, _, x_re, x_im = lax.associative_scan(combine, (a_seq_re, a_seq_im, bu_re, bu_im), axis=0)
    y = (jnp.einsum('sbgp,gcp->bsgc', x_re, c_re.astype(f32))
         - jnp.einsum('sbgp,gcp->bsgc', x_im, c_im.astype(f32))
         + d_skip.astype(f32) * uf)
    return y.reshape(bsz, s, SSM_WIDTH).astype(u.dtype)


def moba_attention(q, k, v):
    out_dtype = q.dtype
    f32 = jnp.float32
    bsz, h, s, dh = q.shape
    n_blk = -(-s // MOBA_BLOCK)
    s_pad = n_blk * MOBA_BLOCK
    pad = ((0, 0), (0, 0), (0, s_pad - s), (0, 0))
    q = jnp.pad(q.astype(f32), pad)
    k = jnp.pad(k.astype(f32), pad)
    v = jnp.pad(v.astype(f32), pad)
    kb = k.reshape(bsz, h, n_blk, MOBA_BLOCK, dh)
    vb = v.reshape(bsz, h, n_blk, MOBA_BLOCK, dh)
    k_mean = jnp.mean(kb, axis=3)
    q_blk = jnp.arange(s_pad) // MOBA_BLOCK
    gate = jnp.einsum('bhtd,bhnd->bhtn', q, k_mean)
    fully_past = jnp.arange(n_blk)[None, :] < q_blk[:, None]
    gate = jnp.where(fully_past, gate, -jnp.inf)
    top_k = min(MOBA_TOPK, n_blk)
    _, sel = lax.top_k(gate, top_k)

    n_chunk = s_pad // Q_CHUNK

    def to_chunks(a):
        a = a.reshape((bsz, h, n_chunk, Q_CHUNK) + a.shape[3:])
        return jnp.moveaxis(a, 2, 0)

    slopes = alibi_slopes(h)[None, :, None, None]
    b_ix = jnp.arange(bsz)[:, None, None, None]
    h_ix = jnp.arange(h)[None, :, None, None]
    offs = jnp.arange(MOBA_BLOCK)
    scale = HEAD_DIM ** -0.5
    n_sel = top_k * MOBA_BLOCK

    def chunk_attn(args):
        qc, selc, ci = args
        t = ci * Q_CHUNK + jnp.arange(Q_CHUNK)
        own = t[0] // MOBA_BLOCK
        kg = kb[b_ix, h_ix, selc].reshape(bsz, h, Q_CHUNK, n_sel, dh)
        vg = vb[b_ix, h_ix, selc].reshape(bsz, h, Q_CHUNK, n_sel, dh)
        s_sel = (selc[..., None] * MOBA_BLOCK + offs).reshape(bsz, h, Q_CHUNK, n_sel)
        ok_sel = jnp.broadcast_to((selc < own)[..., None], selc.shape + (MOBA_BLOCK,)).reshape(bsz, h, Q_CHUNK, n_sel)
        l_sel = jnp.einsum('bhcd,bhckd->bhck', qc, kg) * scale - slopes * (t[:, None] - s_sel)
        l_sel = jnp.where(ok_sel, l_sel, -jnp.inf)
        ko = lax.dynamic_slice_in_dim(k, own * MOBA_BLOCK, MOBA_BLOCK, axis=2)
        vo = lax.dynamic_slice_in_dim(v, own * MOBA_BLOCK, MOBA_BLOCK, axis=2)
        s_own = own * MOBA_BLOCK + offs
        dist_own = t[:, None] - s_own[None, :]
        l_own = jnp.einsum('bhcd,bhkd->bhck', qc, ko) * scale - slopes * dist_own
        l_own = jnp.where(dist_own >= 0, l_own, -jnp.inf)
        p = jax.nn.softmax(jnp.concatenate([l_sel, l_own], axis=-1), axis=-1)
        o = (jnp.einsum('bhck,bhckd->bhcd', p[..., :n_sel], vg)
             + jnp.einsum('bhck,bhkd->bhcd', p[..., n_sel:], vo))
        return o

    out = lax.map(chunk_attn, (to_chunks(q), to_chunks(sel), jnp.arange(n_chunk)))
    out = jnp.moveaxis(out, 0, 2).reshape(bsz, h, s_pad, dh)[:, :, :s]
    return out.astype(out_dtype)


def parallel_mixer(hn, w_in, a_re, a_im, log_dt, b_re, b_im, c_re, c_im, d_skip,
                   w_glu_a, w_glu_b, w_attn_out, w_out):
    bsz, s, _ = hn.shape
    proj = hn @ w_in
    cuts = [SSM_WIDTH, SSM_WIDTH + ATTN_WIDTH, SSM_WIDTH + 2 * ATTN_WIDTH, SSM_WIDTH + 3 * ATTN_WIDTH]
    u, q, k, v, g = jnp.split(proj, cuts, axis=-1)
    z = jax.nn.gelu(s5_ssm(u, a_re, a_im, log_dt, b_re, b_im, c_re, c_im, d_skip))
    y_a = (z @ w_glu_a) * jax.nn.sigmoid(z @ w_glu_b)
    to_heads = lambda t: t.reshape(bsz, s, ATTN_HEADS, HEAD_DIM).transpose(0, 2, 1, 3)
    o = moba_attention(to_heads(q), to_heads(k), to_heads(v))
    y_b = o.transpose(0, 2, 1, 3).reshape(bsz, s, ATTN_WIDTH) @ w_attn_out
    g_a, g_b = jnp.split(jax.nn.sigmoid(g), N_BRANCH, axis=-1)
    return (g_a * y_a + g_b * y_b) @ w_out


def swiglu_ffn(hn, w_gate, w_up, w_down):
    return (jax.nn.silu(hn @ w_gate) * (hn @ w_up)) @ w_down


def setup_inputs(seed: int = 0) -> dict:
    key = jax.random.key(seed)
    ks = jax.random.split(key, 24)
    f32 = jnp.float32
    nrm = lambda k, shape, s: jax.random.normal(k, shape, f32) * s
    L, G, P, C = DEPTH, SSM_GROUPS, SSM_STATE, SSM_GROUP
    n_idx = jnp.arange(P, dtype=f32)
    return {
        "x": nrm(ks[0], (BATCH, SEQ, D_MODEL), 1.0),
        "c": nrm(ks[1], (BATCH, D_MODEL), 1.0),
        "w_ada": nrm(ks[2], (L, D_MODEL, N_MOD * D_MODEL), 0.2 * D_MODEL ** -0.5),
        "b_ada": nrm(ks[3], (L, N_MOD * D_MODEL), 0.01),
        "g_pre_mix": 1.0 + nrm(ks[4], (L, D_MODEL), 0.02),
        "g_post_mix": 1.0 + nrm(ks[5], (L, D_MODEL), 0.02),
        "w_in": nrm(ks[6], (L, D_MODEL, IN_WIDTH), D_MODEL ** -0.5),
        "ssm_a_re": -0.5 * jnp.exp(nrm(ks[7], (L, G, P), 0.02)),
        "ssm_a_im": math.pi * n_idx + nrm(ks[8], (L, G, P), 0.01),
        "ssm_log_dt": jax.random.uniform(ks[9], (L, G), f32, math.log(DT_MIN), math.log(DT_MAX)),
        "ssm_b_re": nrm(ks[10], (L, G, P, C), (2 * C) ** -0.5),
        "ssm_b_im": nrm(ks[11], (L, G, P, C), (2 * C) ** -0.5),
        "ssm_c_re": nrm(ks[12], (L, G, C, P), P ** -0.5),
        "ssm_c_im": nrm(ks[13], (L, G, C, P), P ** -0.5),
        "ssm_d": nrm(ks[14], (L, G, C), 1.0),
        "w_glu_a": nrm(ks[15], (L, SSM_WIDTH, D_MODEL), SSM_WIDTH ** -0.5),
        "w_glu_b": nrm(ks[16], (L, SSM_WIDTH, D_MODEL), SSM_WIDTH ** -0.5),
        "w_attn_out": nrm(ks[17], (L, ATTN_WIDTH, D_MODEL), ATTN_WIDTH ** -0.5),
        "w_out": nrm(ks[18], (L, D_MODEL, D_MODEL), D_MODEL ** -0.5),
        "g_pre_ffn": 1.0 + nrm(ks[19], (L, D_MODEL), 0.02),
        "g_post_ffn": 1.0 + nrm(ks[20], (L, D_MODEL), 0.02),
        "w_ff_gate": nrm(ks[21], (L, D_MODEL, D_FF), D_MODEL ** -0.5),
        "w_ff_up": nrm(ks[22], (L, D_MODEL, D_FF), D_MODEL ** -0.5),
        "w_ff_down": nrm(ks[23], (L, D_FF, D_MODEL), D_FF ** -0.5),
    }


def reference(x, c, w_ada, b_ada, g_pre_mix, g_post_mix, w_in, ssm_a_re, ssm_a_im, ssm_log_dt,
              ssm_b_re, ssm_b_im, ssm_c_re, ssm_c_im, ssm_d, w_glu_a, w_glu_b, w_attn_out, w_out,
              g_pre_ffn, g_post_ffn, w_ff_gate, w_ff_up, w_ff_down):
    c_act = jax.nn.silu(c)
    for l in range(DEPTH):
        mod = c_act @ w_ada[l] + b_ada[l]
        sh_m, sc_m, gt_m, sh_f, sc_f, gt_f = [m[:, None, :] for m in jnp.split(mod, N_MOD, axis=-1)]
        hn = rms_norm(x, g_pre_mix[l]) * (1.0 + sc_m) + sh_m
        y = parallel_mixer(hn, w_in[l], ssm_a_re[l], ssm_a_im[l], ssm_log_dt[l], ssm_b_re[l], ssm_b_im[l],
                           ssm_c_re[l], ssm_c_im[l], ssm_d[l], w_glu_a[l], w_glu_b[l], w_attn_out[l], w_out[l])
        x = x + gt_m * rms_norm(y, g_post_mix[l])
        hn = rms_norm(x, g_pre_ffn[l]) * (1.0 + sc_f) + sh_f
        y = swiglu_ffn(hn, w_ff_gate[l], w_ff_up[l], w_ff_down[l])
        x = x + gt_f * rms_norm(y, g_post_ffn[l])
    return x
```

```cpp
#include <hip/hip_runtime.h>
#include <cstdio>
#include <cstdint>

constexpr int NB = 4, SEQ = 8192, DM = 1024, MT = NB * SEQ;
constexpr int SSM_W = 512, NGRP = 32, GCH = 16, NST = 64;
constexpr int NH = 8, HD = 64, AW = 512, MBLK = 256, NBLK = SEQ / MBLK, TOPK = 3;
constexpr int INW = 4096, FF = 2816, NMOD = 6;
constexpr float NORM_EPS = 1e-6f;
constexpr float LOG2E = 1.4426950408889634f;
constexpr float QSCALE = 0.125f * LOG2E;
namespace pg8 {
#define PG8_LAS __attribute__((address_space(3)))
typedef unsigned short bf16_t;
typedef short bf16x8 __attribute__((ext_vector_type(8)));
typedef float f32x4 __attribute__((ext_vector_type(4)));
typedef unsigned u32x4 __attribute__((ext_vector_type(4)));
constexpr int BM = 256, BK = 64, HALF = 128, HTB = HALF * BK * 2  , STAGE_BYTES = 8 * HTB, NXCD = 8, WGM = 8;

__host__ __device__ __forceinline__ int lds_byte(int r, int c) { const int st = (r >> 4) * 2 + (c >> 5), rr = r & 15, cc = c & 31, ob = rr * 64 + cc * 2; return st * 1024 + (ob ^ (((ob >> 9) & 1) << 5)); }
__host__ __device__ __forceinline__ void stage_rc(int b, int& R, int& C) { const int st = b / 1024, sb = b % 1024, swz = sb ^ (((sb >> 9) & 1) << 5); R = (st >> 1) * 16 + swz / 64; C = (st & 1) * 32 + (swz % 64) / 2; }
__host__ __device__ __forceinline__ int perm32(int rho) { const int n = rho >> 4, i = rho & 15; return 8 * (i >> 2) + 4 * n + (i & 3); }

struct Unit { int pm, pn; };
struct Gemm { const bf16_t* A; const bf16_t* Bt; int M, N, K; };

struct StaticOrder {
    int nM, nN, nwg, G, c;
    __host__ __device__ void init(int M, int N, int G_, int c_) { nM = M / BM; nN = N / BM; nwg = nM * nN; G = G_; c = c_; }
    __host__ __device__ bool next(int i, Unit& u) const {
        const long L = (long)i * G + c; if (L >= nwg) return false;
        int wgid = (int)L; { const int q = nwg / NXCD, r = nwg % NXCD, xcd = wgid % NXCD, off = wgid / NXCD; wgid = (xcd < r ? xcd * (q + 1) : r * (q + 1) + (xcd - r) * q) + off; }
        const int nig = WGM * nN, gid = wgid / nig, fm = gid * WGM, gsz = (nM - fm) < WGM ? (nM - fm) : WGM;
        u.pm = fm + ((wgid % nig) % gsz); u.pn = (wgid % nig) / gsz; return true;
    }
    __device__ __forceinline__ void a_ready(const Unit&) const {}
    __device__ __forceinline__ void done(const Unit&) const {}
};

typedef float f32x2c_t __attribute__((ext_vector_type(2))); typedef __bf16 bf16x2c_t __attribute__((ext_vector_type(2)));
__device__ __forceinline__ unsigned cvt_pk_bf16(float lo, float hi) { f32x2c_t v = {lo, hi}; bf16x2c_t b = __builtin_convertvector(v, bf16x2c_t); return __builtin_bit_cast(unsigned, b); }
typedef float f32x2 __attribute__((ext_vector_type(2)));
__device__ __forceinline__ f32x2 gelu_pk(f32x2 v) {
    const f32x2 av = __builtin_elementwise_abs(v), d = av * 0.2316418882f + 1.0f;
    f32x2 t; t.x = __builtin_amdgcn_rcpf(d.x); t.y = __builtin_amdgcn_rcpf(d.y);
    f32x2 q = t * 0.5307027145f + (-0.7265760135f); q = q * t + 0.7107068705f; q = q * t + (-0.142248368f); q = q * t + 0.127414796f; q = q * t;
    const f32x2 s = (v * v) * (-0.72134752044f);
    f32x2 e; e.x = __builtin_amdgcn_exp2f(s.x); e.y = __builtin_amdgcn_exp2f(s.y);
    const f32x2 m = v * (q * e), r = v - m;
    f32x2 o; o.x = v.x < 0.f ? m.x : r.x; o.y = v.y < 0.f ? m.y : r.y; return o;
}

template <int ACT  > struct EpiBf16 {
    static constexpr bool PERM = true, AFTER_DRAIN = false; static_assert(ACT == 0 || ACT == 1, "EpiBf16: ACT is 0 (none) or 1 (gelu_pk)");
    bf16_t* O; int ldc; const float* bias; int split_cols; size_t split_stride; float scale0;
    __device__ __forceinline__ void operator()(const f32x4 (&acc)[2][2][4][2], const Unit& u, int wr, int wc, int fr, int fq) const {
        const int row0 = u.pm * BM + wr * 64 + fr; int colt = u.pn * BM; bf16_t* base = O;
        float sc = 1.f; if (split_cols) { const int t = colt / split_cols; base += (size_t)t * split_stride; colt -= t * split_cols; if (t == 0) sc = scale0; }
        const int col0 = colt + wc * 32 + 8 * fq, bcol0 = u.pn * BM + wc * 32 + 8 * fq;
        f32x4 bv[2][2];
#pragma unroll
        for (int bj = 0; bj < 2; ++bj)
#pragma unroll
            for (int n = 0; n < 2; ++n) bv[bj][n] = bias ? *(const f32x4*)(bias + bcol0 + bj * HALF + 4 * n) : (f32x4){0.f, 0.f, 0.f, 0.f};
#pragma unroll
        for (int ai = 0; ai < 2; ++ai)
#pragma unroll
            for (int m = 0; m < 4; ++m) { bf16_t* rowp = base + (size_t)(row0 + ai * HALF + m * 16) * ldc + col0;
#pragma unroll
                for (int bj = 0; bj < 2; ++bj) { f32x4 v0 = acc[ai][bj][m][0] + bv[bj][0], v1 = acc[ai][bj][m][1] + bv[bj][1];
                    if (ACT == 1) { f32x2 a = gelu_pk((f32x2){v0[0], v0[1]}), b = gelu_pk((f32x2){v0[2], v0[3]}), c = gelu_pk((f32x2){v1[0], v1[1]}), d = gelu_pk((f32x2){v1[2], v1[3]});
                        v0 = (f32x4){a.x, a.y, b.x, b.y}; v1 = (f32x4){c.x, c.y, d.x, d.y}; }
                    v0 = v0 * sc; v1 = v1 * sc; u32x4 w; w.x = cvt_pk_bf16(v0[0], v0[1]); w.y = cvt_pk_bf16(v0[2], v0[3]); w.z = cvt_pk_bf16(v1[0], v1[1]); w.w = cvt_pk_bf16(v1[2], v1[3]);
                    *(u32x4*)(rowp + bj * HALF) = w; } }
    }
};


__device__ __forceinline__ float sigm(float x) { return __builtin_amdgcn_rcpf(1.0f + __builtin_amdgcn_exp2f(-1.4426950408889634f * x)); }
__device__ __forceinline__ f32x4 sigm4(f32x4 v) { return (f32x4){sigm(v[0]), sigm(v[1]), sigm(v[2]), sigm(v[3])}; }
__device__ __forceinline__ u32x4 pack8(f32x4 v0, f32x4 v1) { u32x4 w; w.x = cvt_pk_bf16(v0[0], v0[1]); w.y = cvt_pk_bf16(v0[2], v0[3]); w.z = cvt_pk_bf16(v1[0], v1[1]); w.w = cvt_pk_bf16(v1[2], v1[3]); return w; }
__device__ __forceinline__ void unpack8(u32x4 w, f32x4& v0, f32x4& v1) {
    v0 = (f32x4){__uint_as_float(w.x << 16), __uint_as_float(w.x & 0xffff0000u), __uint_as_float(w.y << 16), __uint_as_float(w.y & 0xffff0000u)};
    v1 = (f32x4){__uint_as_float(w.z << 16), __uint_as_float(w.z & 0xffff0000u), __uint_as_float(w.w << 16), __uint_as_float(w.w & 0xffff0000u)};
}

struct EpiProj {
    static constexpr bool PERM = true, AFTER_DRAIN = false;
    bf16_t *UG, *QH, *G; size_t qkv_stride; float qscale;
    __device__ __forceinline__ void operator()(const f32x4 (&acc)[2][2][4][2], const Unit& u, int wr, int wc, int fr, int fq) const {
        const int pn = u.pn, row0 = u.pm * BM + wr * 64 + fr, cw = wc * 32 + 8 * fq;
        if (pn >= 8) {
#pragma unroll
            for (int ai = 0; ai < 2; ++ai)
#pragma unroll
                for (int m = 0; m < 4; ++m) { const int r = row0 + ai * HALF + m * 16; bf16_t* rowp = G + (size_t)r * 2048 + (pn * 256 - 2048) + cw;
#pragma unroll
                    for (int bj = 0; bj < 2; ++bj) *(u32x4*)(rowp + bj * HALF) = pack8(sigm4(acc[ai][bj][m][0]), sigm4(acc[ai][bj][m][1])); }
        } else if (pn >= 2) {
            const int t = (pn - 2) >> 1; bf16_t* base = QH + (size_t)t * qkv_stride; const float sc = t == 0 ? qscale : 1.0f;
#pragma unroll
            for (int ai = 0; ai < 2; ++ai)
#pragma unroll
                for (int m = 0; m < 4; ++m) { const int r = row0 + ai * HALF + m * 16, b = r >> 13, s = r & 8191;
#pragma unroll
                    for (int bj = 0; bj < 2; ++bj) { const int cc = (pn & 1) * 256 + bj * 128 + cw, h = cc >> 6, d = cc & 63;
                        bf16_t* dst = base + ((size_t)((b * 8 + h) * 8192 + s)) * 64 + d;
                        *(u32x4*)dst = pack8(acc[ai][bj][m][0] * sc, acc[ai][bj][m][1] * sc); } }
        } else {
#pragma unroll
            for (int ai = 0; ai < 2; ++ai)
#pragma unroll
                for (int m = 0; m < 4; ++m) { const int r = row0 + ai * HALF + m * 16, b = r >> 13, s = r & 8191;
#pragma unroll
                    for (int bj = 0; bj < 2; ++bj) { const int cc = pn * 256 + bj * 128 + cw, g = cc >> 4;
                        bf16_t* dst = UG + ((size_t)((b * 32 + g) * 8192 + s)) * 16 + (cc & 8);
                        *(u32x4*)dst = pack8(acc[ai][bj][m][0], acc[ai][bj][m][1]); } }
        }
    }
};
struct EpiGlu {
    static constexpr bool PERM = true, AFTER_DRAIN = false;
    const bf16_t* G; bf16_t* T1;
    __device__ __forceinline__ void operator()(const f32x4 (&acc)[2][2][4][2], const Unit& u, int wr, int wc, int fr, int fq) const {
        const int row0 = u.pm * BM + wr * 64 + fr, col = u.pn * 128 + wc * 32 + 8 * fq;
#pragma unroll
        for (int ai = 0; ai < 2; ++ai)
#pragma unroll
            for (int m = 0; m < 4; ++m) { const int r = row0 + ai * HALF + m * 16;
                f32x4 g0, g1; unpack8(*(const u32x4*)(G + (size_t)r * 2048 + col), g0, g1);
                const f32x4 t0 = acc[ai][0][m][0] * sigm4(acc[ai][1][m][0]) * g0, t1 = acc[ai][0][m][1] * sigm4(acc[ai][1][m][1]) * g1;
                *(u32x4*)(T1 + (size_t)r * 1024 + col) = pack8(t0, t1); }
    }
};
struct EpiMerge {
    static constexpr bool PERM = true, AFTER_DRAIN = false;
    const bf16_t* G; const bf16_t* T1; bf16_t* MG;
    __device__ __forceinline__ void operator()(const f32x4 (&acc)[2][2][4][2], const Unit& u, int wr, int wc, int fr, int fq) const {
        const int row0 = u.pm * BM + wr * 64 + fr, col0 = u.pn * BM + wc * 32 + 8 * fq;
#pragma unroll
        for (int ai = 0; ai < 2; ++ai)
#pragma unroll
            for (int m = 0; m < 4; ++m) { const int r = row0 + ai * HALF + m * 16;
#pragma unroll
                for (int bj = 0; bj < 2; ++bj) { const int col = col0 + bj * HALF;
                    f32x4 g0, g1, t0, t1; unpack8(*(const u32x4*)(G + (size_t)r * 2048 + 1024 + col), g0, g1); unpack8(*(const u32x4*)(T1 + (size_t)r * 1024 + col), t0, t1);
                    *(u32x4*)(MG + (size_t)r * 1024 + col) = pack8(t0 + g0 * acc[ai][bj][m][0], t1 + g1 * acc[ai][bj][m][1]); } }
    }
};
struct EpiSwiGlu {
    static constexpr bool PERM = true, AFTER_DRAIN = false;
    bf16_t* H;
    __device__ __forceinline__ void operator()(const f32x4 (&acc)[2][2][4][2], const Unit& u, int wr, int wc, int fr, int fq) const {
        const int row0 = u.pm * BM + wr * 64 + fr, col = u.pn * 128 + wc * 32 + 8 * fq;
#pragma unroll
        for (int ai = 0; ai < 2; ++ai)
#pragma unroll
            for (int m = 0; m < 4; ++m) { const int r = row0 + ai * HALF + m * 16;
                const f32x4 a0 = acc[ai][0][m][0], a1 = acc[ai][0][m][1];
                *(u32x4*)(H + (size_t)r * 2816 + col) = pack8(a0 * sigm4(a0) * acc[ai][1][m][0], a1 * sigm4(a1) * acc[ai][1][m][1]); }
    }
};
struct EpiF32 {
    static constexpr bool PERM = false, AFTER_DRAIN = false;
    float* C; int ldc;
    __device__ __forceinline__ void operator()(const f32x4 (&acc)[2][2][4][2], const Unit& u, int wr, int wc, int fr, int fq) const {
        const int row0 = u.pm * BM + wr * 64 + fr, col0 = u.pn * BM + wc * 32 + 4 * fq;
#pragma unroll
        for (int ai = 0; ai < 2; ++ai)
#pragma unroll
            for (int m = 0; m < 4; ++m) { float* rowp = C + (size_t)(row0 + ai * HALF + m * 16) * ldc + col0;
#pragma unroll
                for (int bj = 0; bj < 2; ++bj)
#pragma unroll
                    for (int n = 0; n < 2; ++n) *(f32x4*)(rowp + bj * HALF + n * 16) = acc[ai][bj][m][n]; }
    }
};
template <class Epi, class Sched, bool ALIGN_EPI = false, bool SP2 = false>
__device__ __forceinline__ void gemm_phase(PG8_LAS unsigned char* lds, const Gemm g, const Sched& S, const Epi& E) {
    const int tid = threadIdx.x, wid = __builtin_amdgcn_readfirstlane(tid >> 6), lane = tid & 63, wr = wid >> 2, wc = wid & 3, fr = lane & 15, fq = lane >> 4;
    const int K = g.K, nt = K / BK;
    unsigned voffA[2], voffB[2];
#pragma unroll
    for (int i = 0; i < 2; ++i) { int R, C; stage_rc(tid * 16 + i * 8192, R, C); const int Rb = Epi::PERM ? ((R & ~31) + perm32(R & 31)) : R;
        voffA[i] = (unsigned)(R * K + C) * 2u; voffB[i] = (unsigned)(Rb * K + C) * 2u; }
    const size_t kstep = (size_t)(BK * 2);
    const size_t hstep = (size_t)HALF * K * 2;
    const size_t tstep = 2 * hstep;
    const unsigned ldsw = (unsigned)wid * 1024u;
    const int aoff = lds_byte(wr * 64 + fr, fq * 8), boff = lds_byte(wc * 32 + fr, fq * 8);
#define PG8_SA(b, h) (((b) * 2 + (h)) * HTB)
#define PG8_SB(b, h) ((4 + (b) * 2 + (h)) * HTB)
#define PG8_STAGE(bufoff, gbase, voff) do { _Pragma("unroll") for (int _i = 0; _i < 2; ++_i) \
        __builtin_amdgcn_global_load_lds((const unsigned*)((const char*)(gbase) + (voff)[_i]), (PG8_LAS unsigned*)(lds + (bufoff) + ldsw + _i * 8192), 16, 0, 0); } while (0)
#define PG8_LDA(dst, b, h) do { _Pragma("unroll") for (int m = 0; m < 4; ++m) _Pragma("unroll") for (int k = 0; k < 2; ++k) dst[m][k] = *(const PG8_LAS bf16x8*)(lds + PG8_SA(b, h) + aoff + m * 2048 + k * 1024); } while (0)
#define PG8_LDB(dst, b, h) do { _Pragma("unroll") for (int n = 0; n < 2; ++n) _Pragma("unroll") for (int k = 0; k < 2; ++k) dst[n][k] = *(const PG8_LAS bf16x8*)(lds + PG8_SB(b, h) + boff + n * 2048 + k * 1024); } while (0)
#define PG8_MMA(ai, bj, At, Bt) do { __builtin_amdgcn_s_setprio(1); _Pragma("unroll") for (int m = 0; m < 4; ++m) _Pragma("unroll") for (int n = 0; n < 2; ++n) _Pragma("unroll") for (int k = 0; k < 2; ++k) \
        acc[ai][bj][m][n] = __builtin_amdgcn_mfma_f32_16x16x32_bf16(Bt[n][k], At[m][k], acc[ai][bj][m][n], 0, 0, 0); __builtin_amdgcn_s_setprio(0); } while (0)
#define PG8_WAIT_V(n) asm volatile("s_waitcnt vmcnt(" #n ")" ::: "memory")
#define PG8_WAIT_L(n) asm volatile("s_waitcnt lgkmcnt(" #n ")" ::: "memory")
#define PG8_BAR __builtin_amdgcn_s_barrier()
#define PG8_SCHED __builtin_amdgcn_sched_barrier(0)
    Unit cur, nxt; int ui = 0;
    if (!S.next(0, cur)) return;
    f32x4 acc[2][2][4][2];
#pragma unroll
    for (int a = 0; a < 2; ++a)
#pragma unroll
        for (int b = 0; b < 2; ++b)
#pragma unroll
            for (int m = 0; m < 4; ++m)
#pragma unroll
                for (int n = 0; n < 2; ++n) acc[a][b][m][n] = (f32x4){0.f, 0.f, 0.f, 0.f};
    bf16x8 At[4][2], B0[2][2], B1[2][2];
    const char* cA = (const char*)g.A + (size_t)cur.pm * tstep; const char* cB = (const char*)g.Bt + (size_t)cur.pn * tstep;
    S.a_ready(cur);
    if constexpr (SP2) {
        PG8_STAGE(PG8_SB(0, 0), cB, voffB); PG8_STAGE(PG8_SB(0, 1), cB + hstep, voffB); PG8_STAGE(PG8_SA(0, 0), cA, voffA); PG8_STAGE(PG8_SA(0, 1), cA + hstep, voffA);
        if (wr == 1) PG8_BAR;
        PG8_WAIT_V(2); PG8_BAR;
        PG8_STAGE(PG8_SB(1, 0), cB + kstep, voffB); PG8_STAGE(PG8_SA(1, 0), cA + kstep, voffA); PG8_STAGE(PG8_SB(1, 1), cB + hstep + kstep, voffB);
        PG8_WAIT_V(6); PG8_BAR;
    } else {
        PG8_STAGE(PG8_SB(0, 0), cB, voffB); PG8_STAGE(PG8_SA(0, 0), cA, voffA); PG8_STAGE(PG8_SB(0, 1), cB + hstep, voffB); PG8_STAGE(PG8_SA(0, 1), cA + hstep, voffA);
        if (wr == 1) PG8_BAR;
        PG8_WAIT_V(4); PG8_BAR;
        PG8_STAGE(PG8_SB(1, 0), cB + kstep, voffB); PG8_STAGE(PG8_SA(1, 0), cA + kstep, voffA); PG8_STAGE(PG8_SB(1, 1), cB + hstep + kstep, voffB);
        PG8_WAIT_V(6); PG8_BAR;
    }
    for (;;) {
        const bool has_next = S.next(ui + 1, nxt);
        const char* nA = has_next ? (const char*)g.A + (size_t)nxt.pm * tstep : cA; const char* nB = has_next ? (const char*)g.Bt + (size_t)nxt.pn * tstep : cB;
        for (int t = 0; t < nt; t += 2) {
            const bool last = (t == nt - 2);
            const char* a1 = cA + (size_t)(t + 1) * kstep;
            const char* a2 = last ? nA : cA + (size_t)(t + 2) * kstep; const char* b2 = last ? nB : cB + (size_t)(t + 2) * kstep;
            const char* a3 = a2 + kstep; const char* b3 = b2 + kstep;
            if (last && has_next) S.a_ready(nxt);
            if constexpr (SP2) {
            PG8_LDB(B0, 0, 0); PG8_LDB(B1, 0, 1); PG8_SCHED; PG8_LDA(At, 0, 0); PG8_STAGE(PG8_SA(1, 1), a1 + hstep, voffA);
            PG8_WAIT_V(8); PG8_WAIT_L(0); PG8_BAR; PG8_MMA(0, 0, At, B0); PG8_MMA(0, 1, At, B1); PG8_BAR; PG8_SCHED;
            PG8_LDA(At, 0, 1); PG8_STAGE(PG8_SB(0, 0), b2, voffB); PG8_STAGE(PG8_SB(0, 1), b2 + hstep, voffB); PG8_STAGE(PG8_SA(0, 0), a2, voffA);
            PG8_WAIT_V(8); PG8_WAIT_L(0); PG8_BAR; PG8_MMA(1, 0, At, B0); PG8_MMA(1, 1, At, B1); PG8_BAR; PG8_SCHED;
            PG8_LDB(B0, 1, 0); PG8_LDB(B1, 1, 1); PG8_SCHED; PG8_LDA(At, 1, 0); PG8_STAGE(PG8_SA(0, 1), a2 + hstep, voffA);
            PG8_WAIT_V(8); PG8_WAIT_L(0); PG8_BAR; PG8_MMA(0, 0, At, B0); PG8_MMA(0, 1, At, B1); PG8_BAR; PG8_SCHED;
            PG8_LDA(At, 1, 1); PG8_STAGE(PG8_SB(1, 0), b3, voffB); PG8_STAGE(PG8_SB(1, 1), b3 + hstep, voffB); PG8_STAGE(PG8_SA(1, 0), a3, voffA);
            PG8_WAIT_V(8); PG8_WAIT_L(0); PG8_BAR; PG8_MMA(1, 0, At, B0); PG8_MMA(1, 1, At, B1); PG8_BAR; PG8_SCHED;
            } else {
            PG8_LDB(B0, 0, 0); PG8_SCHED; PG8_LDA(At, 0, 0); PG8_STAGE(PG8_SA(1, 1), a1 + hstep, voffA);
            PG8_WAIT_L(8); PG8_BAR; PG8_WAIT_L(0); PG8_MMA(0, 0, At, B0); PG8_BAR; PG8_SCHED;
            PG8_LDB(B1, 0, 1); PG8_STAGE(PG8_SB(0, 0), b2, voffB);
            PG8_BAR; PG8_WAIT_L(0); PG8_MMA(0, 1, At, B1); PG8_BAR;
            PG8_LDA(At, 0, 1); PG8_STAGE(PG8_SA(0, 0), a2, voffA);
            PG8_BAR; PG8_WAIT_L(0); PG8_MMA(1, 0, At, B0); PG8_BAR; PG8_SCHED;
            PG8_STAGE(PG8_SB(0, 1), b2 + hstep, voffB);
            PG8_WAIT_V(6); PG8_BAR; PG8_MMA(1, 1, At, B1); PG8_BAR;
            PG8_LDB(B0, 1, 0); PG8_SCHED; PG8_LDA(At, 1, 0); PG8_STAGE(PG8_SA(0, 1), a2 + hstep, voffA);
            PG8_WAIT_L(8); PG8_BAR; PG8_WAIT_L(0); PG8_MMA(0, 0, At, B0); PG8_BAR; PG8_SCHED;
            PG8_LDB(B1, 1, 1); PG8_STAGE(PG8_SB(1, 0), b3, voffB);
            PG8_BAR; PG8_WAIT_L(0); PG8_MMA(0, 1, At, B1); PG8_BAR;
            PG8_LDA(At, 1, 1); PG8_STAGE(PG8_SA(1, 0), a3, voffA);
            PG8_BAR; PG8_WAIT_L(0); PG8_MMA(1, 0, At, B0); PG8_BAR; PG8_SCHED;
            PG8_STAGE(PG8_SB(1, 1), b3 + hstep, voffB);
            PG8_WAIT_V(6); PG8_BAR; PG8_MMA(1, 1, At, B1); PG8_BAR;
            }
        }
        if constexpr (ALIGN_EPI) { if (wr == 0) PG8_BAR; }
        if constexpr (!Epi::AFTER_DRAIN) { E(acc, cur, wr, wc, fr, fq); S.done(cur); }
        if (!has_next) break;
#pragma unroll
        for (int a = 0; a < 2; ++a)
#pragma unroll
            for (int b = 0; b < 2; ++b)
#pragma unroll
                for (int m = 0; m < 4; ++m)
#pragma unroll
                    for (int n = 0; n < 2; ++n) acc[a][b][m][n] = (f32x4){0.f, 0.f, 0.f, 0.f};
        cur = nxt; cA = nA; cB = nB; ++ui;
        if constexpr (ALIGN_EPI) { if (wr == 1) PG8_BAR; }
    }
    PG8_WAIT_V(0);
    if constexpr (!ALIGN_EPI) { if (wr == 0) PG8_BAR; }
    PG8_BAR;
    if constexpr (Epi::AFTER_DRAIN) { E.fused(acc, cur, wr, wc, fr, fq, lds, wid, lane); S.done(cur); }
#undef PG8_SA
#undef PG8_SB
#undef PG8_STAGE
#undef PG8_LDA
#undef PG8_LDB
#undef PG8_MMA
#undef PG8_WAIT_V
#undef PG8_WAIT_L
#undef PG8_BAR
#undef PG8_SCHED
}
}
#define GAS __attribute__((address_space(1)))
#define LAS __attribute__((address_space(3)))
typedef unsigned short bf16;
typedef unsigned v4u __attribute__((ext_vector_type(4)));
typedef float f32x4 __attribute__((ext_vector_type(4)));
typedef short bf16x8 __attribute__((ext_vector_type(8)));
typedef GAS unsigned gu32;
typedef GAS unsigned long long gu64;
#define RLX_AGENT __ATOMIC_RELAXED, __HIP_MEMORY_SCOPE_AGENT
#define LDS_WAIT() asm volatile("s_waitcnt lgkmcnt(0)" ::: "memory")
#define VM_WAIT() asm volatile("s_waitcnt vmcnt(0)" ::: "memory")
__device__ __forceinline__ unsigned long long rt() { return __builtin_amdgcn_s_memrealtime(); }
__device__ __forceinline__ unsigned f2bf(float f) { unsigned u = __builtin_bit_cast(unsigned, f); return (u + 0x7fffu + ((u >> 16) & 1u)) >> 16; }
__device__ __forceinline__ unsigned pk2(float lo, float hi) { return f2bf(lo) | (f2bf(hi) << 16); }

#define XB_TMO      128
#define XB_XCNT(j)  (256  + 64 * (j))
#define XB_XSUB(j)  (1280 + 64 * (j))
#define XB_XGEN(j)  (2304 + 64 * (j))
#define XB_TOP      3328
#define XB_TOPGEN   3392
#define XCD_BAR_WORDS 3456
#define XB_SPIN_CAP (1u << 18)

__device__ __forceinline__ unsigned xb_ld(unsigned* p)              { return __hip_atomic_load(p, __ATOMIC_RELAXED, __HIP_MEMORY_SCOPE_AGENT); }
__device__ __forceinline__ unsigned xb_add(unsigned* p, unsigned v) { return __hip_atomic_fetch_add(p, v, __ATOMIC_RELAXED, __HIP_MEMORY_SCOPE_AGENT); }
__device__ __forceinline__ unsigned xb_xcc_id() { return (unsigned)__builtin_amdgcn_s_getreg((3 << 11) | 20) & 0xFu; }
#define XB_SPIN(cond, bar) do { unsigned _sp = 0; while (cond) { __builtin_amdgcn_s_sleep(1); \
    if ((++_sp & 255u) == 0u) { if (xb_ld(&(bar)[XB_TMO])) break; if (_sp > XB_SPIN_CAP) { atomicAdd(&(bar)[XB_TMO], 1u); break; } } } } while (0)

struct XcdBarrier {
    unsigned* bar; unsigned x;
    volatile LAS unsigned* st;
};

__device__ __forceinline__ XcdBarrier xcd_barrier_post(unsigned* bar, volatile LAS unsigned* st) {
    XcdBarrier b; b.bar = bar; b.x = xb_xcc_id(); b.st = st;
    if (threadIdx.x == 0) (void)xb_add(&bar[XB_XCNT(b.x)], 1u);
    return b;
}
__device__ __forceinline__ void xcd_barrier_complete(unsigned* bar, unsigned x, unsigned& nloc, unsigned& nx) {
    const unsigned G = gridDim.x * gridDim.y * gridDim.z;
    unsigned sum, cnt, mine, sp = 0u;
    for (;;) {
        sum = 0u; cnt = 0u; mine = 0u;
#pragma unroll
        for (unsigned j = 0; j < 16; ++j) { const unsigned c = xb_ld(&bar[XB_XCNT(j)]); sum += c; cnt += (c > 0u) ? 1u : 0u; mine = (j == x) ? c : mine; }
        if (sum == G) break;
        __builtin_amdgcn_s_sleep(1);
        if ((++sp & 255u) == 0u) { if (xb_ld(&bar[XB_TMO])) break; if (sp > XB_SPIN_CAP) { atomicAdd(&bar[XB_TMO], 1u); break; } }
    }
    nloc = mine > 0u ? mine : 1u; nx = cnt > 0u ? cnt : 1u;
}

__device__ __forceinline__ void xcd_barrier(const XcdBarrier& b) {
    asm volatile("s_waitcnt vmcnt(0)" ::: "memory");
    __syncthreads();
    if (threadIdx.x == 0) {
        unsigned* bar = b.bar;
        __builtin_amdgcn_s_waitcnt(0);
        unsigned nloc = b.st[0], nx = b.st[1];
        if (nloc == 0u) { xcd_barrier_complete(bar, b.x, nloc, nx); b.st[0] = nloc; b.st[1] = nx; }
        const unsigned old = xb_add(&bar[XB_XSUB(b.x)], 1u);
        const unsigned gen = old / nloc;
        if (old + 1u == (gen + 1u) * nloc) {
            __builtin_amdgcn_fence(__ATOMIC_RELEASE, "agent");
            asm volatile("s_waitcnt vmcnt(0)" ::: "memory");
            const unsigned og = xb_add(&bar[XB_TOP], 1u);
            const unsigned tg = og / nx;
            if (og + 1u == (tg + 1u) * nx) xb_add(&bar[XB_TOPGEN], 1u);
            else XB_SPIN(xb_ld(&bar[XB_TOPGEN]) == tg, bar);
            __builtin_amdgcn_fence(__ATOMIC_ACQUIRE, "agent");
            xb_add(&bar[XB_XGEN(b.x)], 1u);
            asm volatile("s_waitcnt vmcnt(0)" ::: "memory");
        } else {
            XB_SPIN(xb_ld(&bar[XB_XGEN(b.x)]) == gen, bar);
            __builtin_amdgcn_fence(__ATOMIC_ACQUIRE, "agent");
            asm volatile("s_waitcnt vmcnt(0)" ::: "memory");
        }
    }
    __syncthreads();
}

constexpr size_t MiB = 1u << 20;
constexpr size_t WS_CTL = 0, CTL_ZERO_BYTES = 1 * MiB;
constexpr size_t WS_MOD = 1 * MiB;
constexpr size_t WS_KMEAN = 1 * MiB + 256 * 1024;
constexpr size_t WS_SSMT = 2 * MiB;
constexpr size_t WS_WIN = 28 * MiB, WS_WGLU = 36 * MiB, WS_WAO = 38 * MiB, WS_WOUT = 39 * MiB, WS_WGU = 41 * MiB, WS_WDN = 52 * MiB;
constexpr size_t WS_HN = 58 * MiB;
constexpr size_t WS_UG = 122 * MiB, WS_QH = 154 * MiB, WS_KH = 186 * MiB, WS_VH = 218 * MiB, WS_VT = 250 * MiB;
constexpr size_t WS_G = 282 * MiB;
constexpr size_t WS_Z = 410 * MiB, WS_O = 442 * MiB;
constexpr size_t WS_T1 = 122 * MiB;
constexpr size_t WS_MG = 186 * MiB;
constexpr size_t WS_H = 122 * MiB;
constexpr size_t WS_Y1 = 282 * MiB;
constexpr size_t WS_Y2 = 298 * MiB;
constexpr size_t WS_END = 474 * MiB;

constexpr int RING_OFF = 0, RING_BYTES = 131072;
constexpr int LDSCTL_OFF = RING_BYTES, MISC_OFF = LDSCTL_OFF + 320;
constexpr int LDS_BYTES = 147456;
constexpr int NWAVES = 8, NTHREADS = 512;

__device__ __forceinline__ float bf2f(bf16 b) { return __uint_as_float(((unsigned)b) << 16); }
__device__ __forceinline__ float wave_sum(float v) {
#pragma unroll
    for (int o = 1; o < 64; o <<= 1) v += __shfl_xor(v, o);
    return v;
}
__device__ __forceinline__ float wave_max(float v) {
#pragma unroll
    for (int o = 1; o < 64; o <<= 1) v = fmaxf(v, __shfl_xor(v, o));
    return v;
}

struct Frame {
    LAS unsigned char* lds;
    int tid, lane, wave, vcu, G;
    const float* in[24]; float* out; unsigned char* ws;
};
enum { I_X = 0, I_C, I_WADA, I_BADA, I_GPRE_MIX, I_GPOST_MIX, I_WIN, I_ARE, I_AIM, I_LOGDT, I_BRE, I_BIM, I_CRE, I_CIM, I_SD, I_WGLUA, I_WGLUB, I_WAO, I_WOUT, I_GPRE_FFN, I_GPOST_FFN, I_WGATE, I_WUP, I_WDOWN };

__device__ __forceinline__ void transpose_item(const float* W, int K, int N, bf16* WT, int k0, int n0, int drow0, LAS float* scr, int lane) {
#pragma unroll 8
    for (int i = 0; i < 32; ++i) { const int kk = 2 * i + (lane >> 5); scr[kk * 33 + (lane & 31)] = W[(size_t)(k0 + kk) * N + n0 + (lane & 31)]; }
    LDS_WAIT(); asm volatile("" ::: "memory");
    const int c = lane & 7;
#pragma unroll
    for (int j = 0; j < 4; ++j) { const int n = (lane >> 3) + 8 * j; const LAS float* s = scr + (8 * c) * 33 + n;
        v4u o; o.x = pk2(s[0 * 33], s[1 * 33]); o.y = pk2(s[2 * 33], s[3 * 33]); o.z = pk2(s[4 * 33], s[5 * 33]); o.w = pk2(s[6 * 33], s[7 * 33]);
        *(GAS v4u*)(WT + (size_t)(drow0 + n) * K + k0 + 8 * c) = o; }
    LDS_WAIT(); asm volatile("" ::: "memory");
}
__device__ __forceinline__ int ilv_row(int n0, int which) { return 256 * (n0 >> 7) + 128 * which + (n0 & 127); }

__device__ __forceinline__ void p0a_weights_mod(Frame& F) {
    LAS float* scr = (LAS float*)(F.lds + RING_OFF + F.wave * 16384);
    const int gw = F.vcu * NWAVES + F.wave, NGW = F.G * NWAVES;
    bf16* WIN = (bf16*)(F.ws + WS_WIN); bf16* WGLU = (bf16*)(F.ws + WS_WGLU); bf16* WAO = (bf16*)(F.ws + WS_WAO); bf16* WOUT = (bf16*)(F.ws + WS_WOUT); bf16* WGU = (bf16*)(F.ws + WS_WGU); bf16* WDN = (bf16*)(F.ws + WS_WDN);
    constexpr int I_IN = 16 * 128, I_GA = 8 * 32, I_AO = 8 * 32, I_OUT = 16 * 32, I_GT = 16 * 88, I_DN = 44 * 32;
    constexpr int NITEMS = I_IN + 2 * I_GA + I_AO + I_OUT + 2 * I_GT + I_DN;
    for (int it = gw; it < NITEMS; it += NGW) {
        int r = it;
        if (r < I_IN) { const int kb = r / 128, nb = r % 128; transpose_item(F.in[I_WIN], 1024, 4096, WIN, 64 * kb, 32 * nb, 32 * nb, scr, F.lane); continue; } r -= I_IN;
        if (r < I_GA) { const int kb = r / 32, nb = r % 32; transpose_item(F.in[I_WGLUA], 512, 1024, WGLU, 64 * kb, 32 * nb, ilv_row(32 * nb, 0), scr, F.lane); continue; } r -= I_GA;
        if (r < I_GA) { const int kb = r / 32, nb = r % 32; transpose_item(F.in[I_WGLUB], 512, 1024, WGLU, 64 * kb, 32 * nb, ilv_row(32 * nb, 1), scr, F.lane); continue; } r -= I_GA;
        if (r < I_AO) { const int kb = r / 32, nb = r % 32; transpose_item(F.in[I_WAO], 512, 1024, WAO, 64 * kb, 32 * nb, 32 * nb, scr, F.lane); continue; } r -= I_AO;
        if (r < I_OUT) { const int kb = r / 32, nb = r % 32; transpose_item(F.in[I_WOUT], 1024, 1024, WOUT, 64 * kb, 32 * nb, 32 * nb, scr, F.lane); continue; } r -= I_OUT;
        if (r < I_GT) { const int kb = r / 88, nb = r % 88; transpose_item(F.in[I_WGATE], 1024, 2816, WGU, 64 * kb, 32 * nb, ilv_row(32 * nb, 0), scr, F.lane); continue; } r -= I_GT;
        if (r < I_GT) { const int kb = r / 88, nb = r % 88; transpose_item(F.in[I_WUP], 1024, 2816, WGU, 64 * kb, 32 * nb, ilv_row(32 * nb, 1), scr, F.lane); continue; } r -= I_GT;
        { const int kb = r / 32, nb = r % 32; transpose_item(F.in[I_WDOWN], 2816, 1024, WDN, 64 * kb, 32 * nb, 32 * nb, scr, F.lane); }
    }
    __syncthreads();
    if (F.vcu < 96) {
        LAS float* cact = (LAS float*)(F.lds + RING_OFF);
        LAS float* red = cact + 4096;
        for (int i = F.tid; i < 4096; i += NTHREADS) { const float cv = F.in[I_C][i]; cact[i] = cv / (1.0f + __expf(-cv)); }
        __syncthreads();
        const float* wada = F.in[I_WADA]; float* mod = (float*)(F.ws + WS_MOD);
        for (int it = F.vcu; it < 96; it += F.G) {
            const int col = F.tid & 63, ks = F.tid >> 6, n = it * 64 + col;
            float a0 = 0.f, a1 = 0.f, a2 = 0.f, a3 = 0.f;
#pragma unroll 4
            for (int k = ks * 128; k < ks * 128 + 128; ++k) { const float w = wada[(size_t)k * 6144 + n]; a0 += cact[k] * w; a1 += cact[1024 + k] * w; a2 += cact[2048 + k] * w; a3 += cact[3072 + k] * w; }
            red[(ks * 4 + 0) * 64 + col] = a0; red[(ks * 4 + 1) * 64 + col] = a1; red[(ks * 4 + 2) * 64 + col] = a2; red[(ks * 4 + 3) * 64 + col] = a3;
            __syncthreads();
            if (F.tid < 256) { const int b = F.tid >> 6, c = F.tid & 63; float s = F.in[I_BADA][it * 64 + c];
#pragma unroll
                for (int q = 0; q < 8; ++q) s += red[(q * 4 + b) * 64 + c];
                mod[b * 6144 + it * 64 + c] = s; }
            __syncthreads();
        }
    }
}

__device__ __forceinline__ void adaln_row(int lane, const float* xrow, const float* gw, const float* sc, const float* sh, bf16* orow) {
    const GAS f32x4* xr = (const GAS f32x4*)xrow + lane;
    f32x4 v[4]; float s = 0.f;
#pragma unroll
    for (int j = 0; j < 4; ++j) { v[j] = xr[64 * j]; s += (v[j].x * v[j].x + v[j].y * v[j].y) + (v[j].z * v[j].z + v[j].w * v[j].w); }
    const float rstd = 1.0f / sqrtf(wave_sum(s) * (1.0f / 1024.0f) + NORM_EPS);
    GAS unsigned long long* o8 = (GAS unsigned long long*)orow + lane;
#pragma unroll
    for (int j = 0; j < 4; ++j) { const f32x4 g4 = ((const GAS f32x4*)gw + lane)[64 * j], sc4 = ((const GAS f32x4*)sc + lane)[64 * j], sh4 = ((const GAS f32x4*)sh + lane)[64 * j];
        const f32x4 o = v[j] * rstd * g4 * (sc4 + 1.0f) + sh4;
        o8[64 * j] = (unsigned long long)pk2(o.x, o.y) | ((unsigned long long)pk2(o.z, o.w) << 32); }
}
__device__ __forceinline__ void p0b_hn(Frame& F) {
    const int gw = F.vcu * NWAVES + F.wave, NGW = F.G * NWAVES;
    const float* mod = (const float*)(F.ws + WS_MOD); bf16* HN = (bf16*)(F.ws + WS_HN);
    for (int m = gw; m < MT; m += NGW) { const int b = m >> 13;
        adaln_row(F.lane, F.in[I_X] + (size_t)m * 1024, F.in[I_GPRE_MIX], mod + b * 6144 + 1024, mod + b * 6144, HN + (size_t)m * 1024); }
}
__device__ __forceinline__ void norm_pass1(Frame& F) {
    const int gw = F.vcu * NWAVES + F.wave, NGW = F.G * NWAVES, lane = F.lane;
    const float* mod = (const float*)(F.ws + WS_MOD); bf16* HN2 = (bf16*)(F.ws + WS_HN); const float* Y = (const float*)(F.ws + WS_Y1);
    for (int m = gw; m < MT; m += NGW) { const int b = m >> 13;
        const GAS f32x4* yr = (const GAS f32x4*)(Y + (size_t)m * 1024) + lane; const GAS f32x4* xr = (const GAS f32x4*)(F.in[I_X] + (size_t)m * 1024) + lane;
        f32x4 y[4], x1[4]; float s = 0.f;
#pragma unroll
        for (int j = 0; j < 4; ++j) { y[j] = yr[64 * j]; s += (y[j].x * y[j].x + y[j].y * y[j].y) + (y[j].z * y[j].z + y[j].w * y[j].w); }
        const float rstd = 1.0f / sqrtf(wave_sum(s) * (1.0f / 1024.0f) + NORM_EPS); float s2 = 0.f;
#pragma unroll
        for (int j = 0; j < 4; ++j) { const f32x4 g4 = ((const GAS f32x4*)F.in[I_GPOST_MIX] + lane)[64 * j], gt4 = ((const GAS f32x4*)(mod + b * 6144 + 2048) + lane)[64 * j];
            x1[j] = xr[64 * j] + gt4 * (y[j] * rstd * g4); ((GAS f32x4*)(F.out + (size_t)m * 1024) + lane)[64 * j] = x1[j];
            s2 += (x1[j].x * x1[j].x + x1[j].y * x1[j].y) + (x1[j].z * x1[j].z + x1[j].w * x1[j].w); }
        const float rstd2 = 1.0f / sqrtf(wave_sum(s2) * (1.0f / 1024.0f) + NORM_EPS);
        GAS unsigned long long* o8 = (GAS unsigned long long*)(HN2 + (size_t)m * 1024) + lane;
#pragma unroll
        for (int j = 0; j < 4; ++j) { const f32x4 g4 = ((const GAS f32x4*)F.in[I_GPRE_FFN] + lane)[64 * j], sc4 = ((const GAS f32x4*)(mod + b * 6144 + 4096) + lane)[64 * j], sh4 = ((const GAS f32x4*)(mod + b * 6144 + 3072) + lane)[64 * j];
            const f32x4 o = x1[j] * rstd2 * g4 * (sc4 + 1.0f) + sh4;
            o8[64 * j] = (unsigned long long)pk2(o.x, o.y) | ((unsigned long long)pk2(o.z, o.w) << 32); }
    }
}
__device__ __forceinline__ void norm_pass2(Frame& F) {
    const int gw = F.vcu * NWAVES + F.wave, NGW = F.G * NWAVES, lane = F.lane;
    const float* mod = (const float*)(F.ws + WS_MOD); const float* Y = (const float*)(F.ws + WS_Y2);
    for (int m = gw; m < MT; m += NGW) { const int b = m >> 13;
        const GAS f32x4* yr = (const GAS f32x4*)(Y + (size_t)m * 1024) + lane; GAS f32x4* xr = (GAS f32x4*)(F.out + (size_t)m * 1024) + lane;
        f32x4 y[4]; float s = 0.f;
#pragma unroll
        for (int j = 0; j < 4; ++j) { y[j] = yr[64 * j]; s += (y[j].x * y[j].x + y[j].y * y[j].y) + (y[j].z * y[j].z + y[j].w * y[j].w); }
        const float rstd = 1.0f / sqrtf(wave_sum(s) * (1.0f / 1024.0f) + NORM_EPS);
#pragma unroll
        for (int j = 0; j < 4; ++j) { const f32x4 g4 = ((const GAS f32x4*)F.in[I_GPOST_FFN] + lane)[64 * j], gt4 = ((const GAS f32x4*)(mod + b * 6144 + 5120) + lane)[64 * j];
            xr[64 * j] = xr[64 * j] + gt4 * (y[j] * rstd * g4); }
    }
}

__device__ __forceinline__ void kmean_phase(Frame& F) {
    const int gw = F.vcu * NWAVES + F.wave, NGW = F.G * NWAVES;
    const bf16* KH = (const bf16*)(F.ws + WS_KH); float* KM = (float*)(F.ws + WS_KMEAN);
    for (int u = gw; u < NB * NH * NBLK; u += NGW) {
        const bf16* kp = KH + (size_t)u * MBLK * 64 + F.lane; float s = 0.f;
#pragma unroll 8
        for (int k = 0; k < MBLK; ++k) s += bf2f(kp[k * 64]);
        KM[u * 64 + F.lane] = s * (1.0f / 256.0f);
    }
}

__device__ __forceinline__ float gelu_tanh(float y) {
    const float a = 0.7978845608028654f * (y + 0.044715f * y * y * y);
    const float e = __builtin_amdgcn_exp2f(2.0f * LOG2E * a);
    const float t = 1.0f - 2.0f * __builtin_amdgcn_rcpf(e + 1.0f);
    return 0.5f * y * (1.0f + t);
}
__device__ __forceinline__ void ssm_simple_phase(Frame& F) {
    const int gw = F.vcu * NWAVES + F.wave, NGW = F.G * NWAVES, lane = F.lane;
    LAS float* Cl = (LAS float*)(F.lds + RING_OFF + F.wave * 16384);
    LAS float* xs = Cl + 16 * 132;
    LAS float* us = xs + 4 * 132;
    const bf16* UG = (const bf16*)(F.ws + WS_UG); bf16* Z = (bf16*)(F.ws + WS_Z);
    for (int unit = gw; unit < NB * NGRP; unit += NGW) {
        const int b = unit >> 5, g = unit & 31, p = lane;
        const float dt = expf(F.in[I_LOGDT][g]), are = F.in[I_ARE][g * 64 + p], aim = F.in[I_AIM][g * 64 + p];
        const float mag = expf(dt * are), abr = mag * cosf(dt * aim), abi = mag * sinf(dt * aim);
        const float den = are * are + aim * aim, nr = abr - 1.0f, cor = (nr * are + abi * aim) / den, coi = (abi * are - nr * aim) / den;
        float bbr[16], bbi[16];
#pragma unroll
        for (int c = 0; c < 16; ++c) { const float br = F.in[I_BRE][(g * 64 + p) * 16 + c], bi = F.in[I_BIM][(g * 64 + p) * 16 + c]; bbr[c] = cor * br - coi * bi; bbi[c] = cor * bi + coi * br; }
#pragma unroll
        for (int c = 0; c < 16; ++c) { Cl[c * 132 + p] = F.in[I_CRE][(g * 16 + c) * 64 + p]; Cl[c * 132 + 64 + p] = -F.in[I_CIM][(g * 16 + c) * 64 + p]; }
        const float dsk = F.in[I_SD][g * 16 + (lane & 15)];
        float xr = 0.f, xi = 0.f;
        const bf16* up = UG + (size_t)(b * 32 + g) * SEQ * 16;
        const int tt = lane >> 4, c = lane & 15;
        for (int t0 = 0; t0 < SEQ; t0 += 4) {
            const float uf = bf2f(up[(size_t)t0 * 16 + lane]);
            us[lane] = uf;
            asm volatile("s_waitcnt lgkmcnt(0)" ::: "memory");
#pragma unroll
            for (int q = 0; q < 4; ++q) {
                float bur = 0.f, bui = 0.f;
#pragma unroll
                for (int cc = 0; cc < 16; ++cc) { const float uv = us[q * 16 + cc]; bur += bbr[cc] * uv; bui += bbi[cc] * uv; }
                const float nxr = abr * xr - abi * xi + bur, nxi = abr * xi + abi * xr + bui; xr = nxr; xi = nxi;
                xs[q * 132 + p] = xr; xs[q * 132 + 64 + p] = xi;
            }
            asm volatile("s_waitcnt lgkmcnt(0)" ::: "memory");
            float y = 0.f;
#pragma unroll 8
            for (int q = 0; q < 128; q += 4) { const f32x4 cv = *(const LAS f32x4*)(Cl + c * 132 + q), xv = *(const LAS f32x4*)(xs + tt * 132 + q); y += (cv.x * xv.x + cv.y * xv.y) + (cv.z * xv.z + cv.w * xv.w); }
            y += dsk * uf;
            Z[(size_t)(b * SEQ + t0 + tt) * 512 + g * 16 + c] = (bf16)f2bf(gelu_tanh(y));
            asm volatile("s_waitcnt lgkmcnt(0)" ::: "memory");
        }
    }
}

__device__ __forceinline__ void attn_simple_phase(Frame& F) {
    const int gw = F.vcu * NWAVES + F.wave, NGW = F.G * NWAVES, lane = F.lane;
    LAS float* qs = (LAS float*)(F.lds + RING_OFF + F.wave * 8192);
    LAS float* lg = qs + 64;
    const bf16* QH = (const bf16*)(F.ws + WS_QH); const bf16* KH = (const bf16*)(F.ws + WS_KH); const bf16* VH = (const bf16*)(F.ws + WS_VH);
    const float* KM = (const float*)(F.ws + WS_KMEAN); bf16* O = (bf16*)(F.ws + WS_O);
    const float NEG = -INFINITY;
    for (int unit = gw; unit < NB * NH * SEQ; unit += NGW) {
        const int t = unit & 8191, bh = unit >> 13, h = bh & 7, b = bh >> 3, qb = t >> 8;
        const float sl2 = exp2f(-(float)(h + 1)) * LOG2E;
        qs[lane] = bf2f(QH[((size_t)bh * SEQ + t) * 64 + lane]);
        asm volatile("s_waitcnt lgkmcnt(0)" ::: "memory");
        float gv = NEG;
        if (lane < qb) { const float* km = KM + ((size_t)bh * 32 + lane) * 64; float s = 0.f;
#pragma unroll 8
            for (int d = 0; d < 64; ++d) s += qs[d] * km[d];
            gv = s; }
        const int nsel = qb < 3 ? qb : 3; int sel0 = 0, sel1 = 0, sel2 = 0;
#pragma unroll
        for (int k = 0; k < 3; ++k) if (k < nsel) {
            const float m = wave_max(gv); const unsigned long long mask = __ballot(gv == m); const int idx = __ffsll((long long)mask) - 1;
            if (k == 0) sel0 = idx; else if (k == 1) sel1 = idx; else sel2 = idx;
            if (lane == idx) gv = NEG; }
        const int nown = t - qb * 256 + 1, nkeys = nsel * 256 + nown;
        const bf16* Kb = KH + (size_t)bh * SEQ * 64; const bf16* Vb = VH + (size_t)bh * SEQ * 64;
        float mx = NEG;
        for (int i = 0; i * 64 < nkeys; ++i) {
            const int kk = i * 64 + lane; const bool valid = kk < nkeys; const int seg = kk >> 8;
            const int blk = (seg < nsel) ? (seg == 0 ? sel0 : (seg == 1 ? sel1 : sel2)) : qb;
            const int pos = valid ? blk * 256 + (kk & 255) : t;
            const GAS v4u* kr = (const GAS v4u*)(Kb + (size_t)pos * 64); float dot = 0.f;
#pragma unroll
            for (int j = 0; j < 8; ++j) { const v4u w = kr[j];
                dot += qs[8 * j + 0] * __uint_as_float(w.x << 16) + qs[8 * j + 1] * __uint_as_float(w.x & 0xffff0000u) + qs[8 * j + 2] * __uint_as_float(w.y << 16) + qs[8 * j + 3] * __uint_as_float(w.y & 0xffff0000u)
                     + qs[8 * j + 4] * __uint_as_float(w.z << 16) + qs[8 * j + 5] * __uint_as_float(w.z & 0xffff0000u) + qs[8 * j + 6] * __uint_as_float(w.w << 16) + qs[8 * j + 7] * __uint_as_float(w.w & 0xffff0000u); }
            const float l = valid ? dot - sl2 * (float)(t - pos) : NEG;
            lg[kk] = l; mx = fmaxf(mx, l);
        }
        mx = wave_max(mx);
        asm volatile("s_waitcnt lgkmcnt(0)" ::: "memory");
        float sum = 0.f;
        for (int i = 0; i * 64 < nkeys; ++i) { const int kk = i * 64 + lane; const float pv = __builtin_amdgcn_exp2f(lg[kk] - mx); lg[kk] = pv; sum += pv; }
        sum = wave_sum(sum);
        asm volatile("s_waitcnt lgkmcnt(0)" ::: "memory");
        float o = 0.f;
        for (int seg = 0; seg <= nsel; ++seg) {
            const int blk = (seg < nsel) ? (seg == 0 ? sel0 : (seg == 1 ? sel1 : sel2)) : qb; const int cnt = (seg < nsel) ? 256 : nown;
            const bf16* vp = Vb + (size_t)blk * 256 * 64 + lane; const LAS float* pp = lg + seg * 256;
#pragma unroll 4
            for (int k = 0; k < cnt; ++k) o += pp[k] * bf2f(vp[(size_t)k * 64]);
        }
        O[((size_t)(b * SEQ + t)) * 512 + h * 64 + lane] = (bf16)f2bf(o / sum);
        asm volatile("s_waitcnt lgkmcnt(0)" ::: "memory");
    }
}

struct Args { const float* in[24]; float* out; unsigned char* ws; int ph_lo, ph_hi; };
constexpr int N_PHASES = 12;
__global__ void __launch_bounds__(NTHREADS, 2) mk_fwd(Args args) {
    extern __shared__ __attribute__((aligned(16))) unsigned char lds[];
    Frame F;
    F.lds = (LAS unsigned char*)lds;
    F.tid = threadIdx.x; F.lane = F.tid & 63; F.wave = __builtin_amdgcn_readfirstlane(F.tid >> 6);
    F.G = gridDim.x; { const int bx = blockIdx.x; F.vcu = (F.G % 8 == 0) ? (bx % 8) * (F.G / 8) + bx / 8 : bx; }
#pragma unroll
    for (int i = 0; i < 24; ++i) F.in[i] = args.in[i];
    F.out = args.out; F.ws = args.ws;
    unsigned char* ws = args.ws;
    const int lo = args.ph_lo, hi = args.ph_hi;
#define IN(k) (lo <= (k) && (k) < hi)
    if (IN(0)) { p0a_weights_mod(F); }
    if (IN(1)) { p0b_hn(F); }
    if (IN(2)) {
        pg8::Gemm g{(const bf16*)(ws + WS_HN), (const bf16*)(ws + WS_WIN), MT, INW, DM}; pg8::StaticOrder S; S.init(MT, INW, F.G, (int)blockIdx.x);
        pg8::EpiProj E{(bf16*)(ws + WS_UG), (bf16*)(ws + WS_QH), (bf16*)(ws + WS_G), (size_t)(WS_KH - WS_QH) / 2, QSCALE};
        static_assert(WS_VH - WS_KH == WS_KH - WS_QH, "q|k|v equally spaced");
        pg8::gemm_phase<pg8::EpiProj, pg8::StaticOrder, true, true>(F.lds + RING_OFF, g, S, E);
    }
    if (IN(3)) { kmean_phase(F); ssm_simple_phase(F); }
    if (IN(4)) { attn_simple_phase(F); }
    if (IN(5)) {
        pg8::Gemm g{(const bf16*)(ws + WS_Z), (const bf16*)(ws + WS_WGLU), MT, 2048, 512}; pg8::StaticOrder S; S.init(MT, 2048, F.G, (int)blockIdx.x);
        pg8::EpiGlu E{(const bf16*)(ws + WS_G), (bf16*)(ws + WS_T1)};
        pg8::gemm_phase<pg8::EpiGlu, pg8::StaticOrder, true, true>(F.lds + RING_OFF, g, S, E);
    }
    if (IN(6)) {
        pg8::Gemm g{(const bf16*)(ws + WS_O), (const bf16*)(ws + WS_WAO), MT, 1024, 512}; pg8::StaticOrder S; S.init(MT, 1024, F.G, (int)blockIdx.x);
        pg8::EpiMerge E{(const bf16*)(ws + WS_G), (const bf16*)(ws + WS_T1), (bf16*)(ws + WS_MG)};
        pg8::gemm_phase<pg8::EpiMerge, pg8::StaticOrder, true, true>(F.lds + RING_OFF, g, S, E);
    }
    if (IN(7)) {
        pg8::Gemm g{(const bf16*)(ws + WS_MG), (const bf16*)(ws + WS_WOUT), MT, 1024, 1024}; pg8::StaticOrder S; S.init(MT, 1024, F.G, (int)blockIdx.x);
        pg8::EpiF32 E{(float*)(ws + WS_Y1), 1024};
        pg8::gemm_phase<pg8::EpiF32, pg8::StaticOrder, true, true>(F.lds + RING_OFF, g, S, E);
    }
    if (IN(8)) { norm_pass1(F); }
    if (IN(9)) {
        pg8::Gemm g{(const bf16*)(ws + WS_HN), (const bf16*)(ws + WS_WGU), MT, 2 * FF, 1024}; pg8::StaticOrder S; S.init(MT, 2 * FF, F.G, (int)blockIdx.x);
        pg8::EpiSwiGlu E{(bf16*)(ws + WS_H)};
        pg8::gemm_phase<pg8::EpiSwiGlu, pg8::StaticOrder, true, true>(F.lds + RING_OFF, g, S, E);
    }
    if (IN(10)) {
        pg8::Gemm g{(const bf16*)(ws + WS_H), (const bf16*)(ws + WS_WDN), MT, 1024, FF}; pg8::StaticOrder S; S.init(MT, 1024, F.G, (int)blockIdx.x);
        pg8::EpiF32 E{(float*)(ws + WS_Y2), 1024};
        pg8::gemm_phase<pg8::EpiF32, pg8::StaticOrder, true, true>(F.lds + RING_OFF, g, S, E);
    }
    if (IN(11)) { norm_pass2(F); }
#undef IN
}

extern "C" void kernel_launch(void* const* d_in, const int* in_sizes, int n_in, void* d_out, int out_size, void* d_ws, size_t ws_size, hipStream_t stream) {
    static int grid = 0;
    if (grid == 0) {
        if (n_in != 24 || in_sizes[0] != MT * DM || out_size != MT * DM || ws_size < WS_END) { fprintf(stderr, "kernel_launch: unexpected shapes (n_in %d, in0 %d, out %d, ws %zu); nothing launched\n", n_in, n_in > 0 ? in_sizes[0] : -1, out_size, ws_size); grid = -1; return; }
        int dev = 0, cus = 0;
        if (hipGetDevice(&dev) != hipSuccess || hipDeviceGetAttribute(&cus, hipDeviceAttributeMultiprocessorCount, dev) != hipSuccess) { grid = -1; return; }
        if (hipFuncSetAttribute((const void*)mk_fwd, hipFuncAttributeMaxDynamicSharedMemorySize, LDS_BYTES) != hipSuccess) { fprintf(stderr, "kernel_launch: hipFuncSetAttribute failed\n"); grid = -1; return; }
        (void)hipGetLastError();
        grid = cus;
    }
    if (grid < 0) return;
    (void)hipMemsetAsync((char*)d_ws + WS_CTL, 0, CTL_ZERO_BYTES, stream);
    Args a{};
    for (int i = 0; i < 24; ++i) a.in[i] = (const float*)d_in[i];
    a.out = (float*)d_out; a.ws = (unsigned char*)d_ws;
    for (int ph = 0; ph < N_PHASES; ++ph) {
        a.ph_lo = ph; a.ph_hi = ph + 1;
        hipLaunchKernelGGL(mk_fwd, dim3(grid), dim3(NTHREADS), LDS_BYTES, stream, a);
    }
}
```

```cpp
#include <hip/hip_runtime.h>
#include <cstdio>
#include <cstdint>

constexpr int NB = 4, SEQ = 8192, DM = 1024, MT = NB * SEQ;
constexpr int SSM_W = 512, NGRP = 32, GCH = 16, NST = 64;
constexpr int NH = 8, HD = 64, AW = 512, MBLK = 256, NBLK = SEQ / MBLK, TOPK = 3;
constexpr int INW = 4096, FF = 2816, NMOD = 6;
constexpr float NORM_EPS = 1e-6f;
constexpr float LOG2E = 1.4426950408889634f;
constexpr float QSCALE = 0.125f * LOG2E;
namespace pg8 {
#define PG8_LAS __attribute__((address_space(3)))
typedef unsigned short bf16_t;
typedef short bf16x8 __attribute__((ext_vector_type(8)));
typedef float f32x4 __attribute__((ext_vector_type(4)));
typedef unsigned u32x4 __attribute__((ext_vector_type(4)));
constexpr int BM = 256, BK = 64, HALF = 128, HTB = HALF * BK * 2  , STAGE_BYTES = 8 * HTB, NXCD = 8, WGM = 8;

__host__ __device__ __forceinline__ int lds_byte(int r, int c) { const int st = (r >> 4) * 2 + (c >> 5), rr = r & 15, cc = c & 31, ob = rr * 64 + cc * 2; return st * 1024 + (ob ^ (((ob >> 9) & 1) << 5)); }
__host__ __device__ __forceinline__ void stage_rc(int b, int& R, int& C) { const int st = b / 1024, sb = b % 1024, swz = sb ^ (((sb >> 9) & 1) << 5); R = (st >> 1) * 16 + swz / 64; C = (st & 1) * 32 + (swz % 64) / 2; }
__host__ __device__ __forceinline__ int perm32(int rho) { const int n = rho >> 4, i = rho & 15; return 8 * (i >> 2) + 4 * n + (i & 3); }

struct Unit { int pm, pn; };
struct Gemm { const bf16_t* A; const bf16_t* Bt; int M, N, K; };

struct StaticOrder {
    int nM, nN, nwg, G, c;
    __host__ __device__ void init(int M, int N, int G_, int c_) { nM = M / BM; nN = N / BM; nwg = nM * nN; G = G_; c = c_; }
    __host__ __device__ bool next(int i, Unit& u) const {
        const long L = (long)i * G + c; if (L >= nwg) return false;
        int wgid = (int)L; { const int q = nwg / NXCD, r = nwg % NXCD, xcd = wgid % NXCD, off = wgid / NXCD; wgid = (xcd < r ? xcd * (q + 1) : r * (q + 1) + (xcd - r) * q) + off; }
        const int nig = WGM * nN, gid = wgid / nig, fm = gid * WGM, gsz = (nM - fm) < WGM ? (nM - fm) : WGM;
        u.pm = fm + ((wgid % nig) % gsz); u.pn = (wgid % nig) / gsz; return true;
    }
    __device__ __forceinline__ void a_ready(const Unit&) const {}
    __device__ __forceinline__ void done(const Unit&) const {}
};

typedef float f32x2c_t __attribute__((ext_vector_type(2))); typedef __bf16 bf16x2c_t __attribute__((ext_vector_type(2)));
__device__ __forceinline__ unsigned cvt_pk_bf16(float lo, float hi) { f32x2c_t v = {lo, hi}; bf16x2c_t b = __builtin_convertvector(v, bf16x2c_t); return __builtin_bit_cast(unsigned, b); }
typedef float f32x2 __attribute__((ext_vector_type(2)));
__device__ __forceinline__ f32x2 gelu_pk(f32x2 v) {
    const f32x2 av = __builtin_elementwise_abs(v), d = av * 0.2316418882f + 1.0f;
    f32x2 t; t.x = __builtin_amdgcn_rcpf(d.x); t.y = __builtin_amdgcn_rcpf(d.y);
    f32x2 q = t * 0.5307027145f + (-0.7265760135f); q = q * t + 0.7107068705f; q = q * t + (-0.142248368f); q = q * t + 0.127414796f; q = q * t;
    const f32x2 s = (v * v) * (-0.72134752044f);
    f32x2 e; e.x = __builtin_amdgcn_exp2f(s.x); e.y = __builtin_amdgcn_exp2f(s.y);
    const f32x2 m = v * (q * e), r = v - m;
    f32x2 o; o.x = v.x < 0.f ? m.x : r.x; o.y = v.y < 0.f ? m.y : r.y; return o;
}

template <int ACT  > struct EpiBf16 {
    static constexpr bool PERM = true, AFTER_DRAIN = false; static_assert(ACT == 0 || ACT == 1, "EpiBf16: ACT is 0 (none) or 1 (gelu_pk)");
    bf16_t* O; int ldc; const float* bias; int split_cols; size_t split_stride; float scale0;
    __device__ __forceinline__ void operator()(const f32x4 (&acc)[2][2][4][2], const Unit& u, int wr, int wc, int fr, int fq) const {
        const int row0 = u.pm * BM + wr * 64 + fr; int colt = u.pn * BM; bf16_t* base = O;
        float sc = 1.f; if (split_cols) { const int t = colt / split_cols; base += (size_t)t * split_stride; colt -= t * split_cols; if (t == 0) sc = scale0; }
        const int col0 = colt + wc * 32 + 8 * fq, bcol0 = u.pn * BM + wc * 32 + 8 * fq;
        f32x4 bv[2][2];
#pragma unroll
        for (int bj = 0; bj < 2; ++bj)
#pragma unroll
            for (int n = 0; n < 2; ++n) bv[bj][n] = bias ? *(const f32x4*)(bias + bcol0 + bj * HALF + 4 * n) : (f32x4){0.f, 0.f, 0.f, 0.f};
#pragma unroll
        for (int ai = 0; ai < 2; ++ai)
#pragma unroll
            for (int m = 0; m < 4; ++m) { bf16_t* rowp = base + (size_t)(row0 + ai * HALF + m * 16) * ldc + col0;
#pragma unroll
                for (int bj = 0; bj < 2; ++bj) { f32x4 v0 = acc[ai][bj][m][0] + bv[bj][0], v1 = acc[ai][bj][m][1] + bv[bj][1];
                    if (ACT == 1) { f32x2 a = gelu_pk((f32x2){v0[0], v0[1]}), b = gelu_pk((f32x2){v0[2], v0[3]}), c = gelu_pk((f32x2){v1[0], v1[1]}), d = gelu_pk((f32x2){v1[2], v1[3]});
                        v0 = (f32x4){a.x, a.y, b.x, b.y}; v1 = (f32x4){c.x, c.y, d.x, d.y}; }
                    v0 = v0 * sc; v1 = v1 * sc; u32x4 w; w.x = cvt_pk_bf16(v0[0], v0[1]); w.y = cvt_pk_bf16(v0[2], v0[3]); w.z = cvt_pk_bf16(v1[0], v1[1]); w.w = cvt_pk_bf16(v1[2], v1[3]);
                    *(u32x4*)(rowp + bj * HALF) = w; } }
    }
};


__device__ __forceinline__ float sigm(float x) { return __builtin_amdgcn_rcpf(1.0f + __builtin_amdgcn_exp2f(-1.4426950408889634f * x)); }
__device__ __forceinline__ f32x4 sigm4(f32x4 v) { return (f32x4){sigm(v[0]), sigm(v[1]), sigm(v[2]), sigm(v[3])}; }
__device__ __forceinline__ u32x4 pack8(f32x4 v0, f32x4 v1) { u32x4 w; w.x = cvt_pk_bf16(v0[0], v0[1]); w.y = cvt_pk_bf16(v0[2], v0[3]); w.z = cvt_pk_bf16(v1[0], v1[1]); w.w = cvt_pk_bf16(v1[2], v1[3]); return w; }
__device__ __forceinline__ void unpack8(u32x4 w, f32x4& v0, f32x4& v1) {
    v0 = (f32x4){__uint_as_float(w.x << 16), __uint_as_float(w.x & 0xffff0000u), __uint_as_float(w.y << 16), __uint_as_float(w.y & 0xffff0000u)};
    v1 = (f32x4){__uint_as_float(w.z << 16), __uint_as_float(w.z & 0xffff0000u), __uint_as_float(w.w << 16), __uint_as_float(w.w & 0xffff0000u)};
}

struct EpiProj {
    static constexpr bool PERM = true, AFTER_DRAIN = false;
    bf16_t *UG, *QH, *G; size_t qkv_stride; float qscale;
    __device__ __forceinline__ void operator()(const f32x4 (&acc)[2][2][4][2], const Unit& u, int wr, int wc, int fr, int fq) const {
        const int pn = u.pn, row0 = u.pm * BM + wr * 64 + fr, cw = wc * 32 + 8 * fq;
        if (pn >= 8) {
#pragma unroll
            for (int ai = 0; ai < 2; ++ai)
#pragma unroll
                for (int m = 0; m < 4; ++m) { const int r = row0 + ai * HALF + m * 16; bf16_t* rowp = G + (size_t)r * 2048 + (pn * 256 - 2048) + cw;
#pragma unroll
                    for (int bj = 0; bj < 2; ++bj) *(u32x4*)(rowp + bj * HALF) = pack8(sigm4(acc[ai][bj][m][0]), sigm4(acc[ai][bj][m][1])); }
        } else if (pn >= 2) {
            const int t = (pn - 2) >> 1; bf16_t* base = QH + (size_t)t * qkv_stride; const float sc = t == 0 ? qscale : 1.0f;
#pragma unroll
            for (int ai = 0; ai < 2; ++ai)
#pragma unroll
                for (int m = 0; m < 4; ++m) { const int r = row0 + ai * HALF + m * 16, b = r >> 13, s = r & 8191;
#pragma unroll
                    for (int bj = 0; bj < 2; ++bj) { const int cc = (pn & 1) * 256 + bj * 128 + cw, h = cc >> 6, d = cc & 63;
                        bf16_t* dst = base + ((size_t)((b * 8 + h) * 8192 + s)) * 64 + d;
                        *(u32x4*)dst = pack8(acc[ai][bj][m][0] * sc, acc[ai][bj][m][1] * sc); } }
        } else {
#pragma unroll
            for (int ai = 0; ai < 2; ++ai)
#pragma unroll
                for (int m = 0; m < 4; ++m) { const int r = row0 + ai * HALF + m * 16, b = r >> 13, s = r & 8191;
#pragma unroll
                    for (int bj = 0; bj < 2; ++bj) { const int cc = pn * 256 + bj * 128 + cw, g = cc >> 4;
                        bf16_t* dst = UG + ((size_t)((b * 32 + g) * 8192 + s)) * 16 + (cc & 8);
                        *(u32x4*)dst = pack8(acc[ai][bj][m][0], acc[ai][bj][m][1]); } }
        }
    }
};
struct EpiGlu {
    static constexpr bool PERM = true, AFTER_DRAIN = false;
    const bf16_t* G; bf16_t* T1;
    __device__ __forceinline__ void operator()(const f32x4 (&acc)[2][2][4][2], const Unit& u, int wr, int wc, int fr, int fq) const {
        const int row0 = u.pm * BM + wr * 64 + fr, col = u.pn * 128 + wc * 32 + 8 * fq;
#pragma unroll
        for (int ai = 0; ai < 2; ++ai)
#pragma unroll
            for (int m = 0; m < 4; ++m) { const int r = row0 + ai * HALF + m * 16;
                f32x4 g0, g1; unpack8(*(const u32x4*)(G + (size_t)r * 2048 + col), g0, g1);
                const f32x4 t0 = acc[ai][0][m][0] * sigm4(acc[ai][1][m][0]) * g0, t1 = acc[ai][0][m][1] * sigm4(acc[ai][1][m][1]) * g1;
                *(u32x4*)(T1 + (size_t)r * 1024 + col) = pack8(t0, t1); }
    }
};
struct EpiMerge {
    static constexpr bool PERM = true, AFTER_DRAIN = false;
    const bf16_t* G; const bf16_t* T1; bf16_t* MG;
    __device__ __forceinline__ void operator()(const f32x4 (&acc)[2][2][4][2], const Unit& u, int wr, int wc, int fr, int fq) const {
        const int row0 = u.pm * BM + wr * 64 + fr, col0 = u.pn * BM + wc * 32 + 8 * fq;
#pragma unroll
        for (int ai = 0; ai < 2; ++ai)
#pragma unroll
            for (int m = 0; m < 4; ++m) { const int r = row0 + ai * HALF + m * 16;
#pragma unroll
                for (int bj = 0; bj < 2; ++bj) { const int col = col0 + bj * HALF;
                    f32x4 g0, g1, t0, t1; unpack8(*(const u32x4*)(G + (size_t)r * 2048 + 1024 + col), g0, g1); unpack8(*(const u32x4*)(T1 + (size_t)r * 1024 + col), t0, t1);
                    *(u32x4*)(MG + (size_t)r * 1024 + col) = pack8(t0 + g0 * acc[ai][bj][m][0], t1 + g1 * acc[ai][bj][m][1]); } }
    }
};
struct EpiSwiGlu {
    static constexpr bool PERM = true, AFTER_DRAIN = false;
    bf16_t* H;
    __device__ __forceinline__ void operator()(const f32x4 (&acc)[2][2][4][2], const Unit& u, int wr, int wc, int fr, int fq) const {
        const int row0 = u.pm * BM + wr * 64 + fr, col = u.pn * 128 + wc * 32 + 8 * fq;
#pragma unroll
        for (int ai = 0; ai < 2; ++ai)
#pragma unroll
            for (int m = 0; m < 4; ++m) { const int r = row0 + ai * HALF + m * 16;
                const f32x4 a0 = acc[ai][0][m][0], a1 = acc[ai][0][m][1];
                *(u32x4*)(H + (size_t)r * 2816 + col) = pack8(a0 * sigm4(a0) * acc[ai][1][m][0], a1 * sigm4(a1) * acc[ai][1][m][1]); }
    }
};
struct EpiF32 {
    static constexpr bool PERM = false, AFTER_DRAIN = false;
    float* C; int ldc;
    __device__ __forceinline__ void operator()(const f32x4 (&acc)[2][2][4][2], const Unit& u, int wr, int wc, int fr, int fq) const {
        const int row0 = u.pm * BM + wr * 64 + fr, col0 = u.pn * BM + wc * 32 + 4 * fq;
#pragma unroll
        for (int ai = 0; ai < 2; ++ai)
#pragma unroll
            for (int m = 0; m < 4; ++m) { float* rowp = C + (size_t)(row0 + ai * HALF + m * 16) * ldc + col0;
#pragma unroll
                for (int bj = 0; bj < 2; ++bj)
#pragma unroll
                    for (int n = 0; n < 2; ++n) *(f32x4*)(rowp + bj * HALF + n * 16) = acc[ai][bj][m][n]; }
    }
};
template <class Epi, class Sched, bool ALIGN_EPI = false, bool SP2 = false>
__device__ __forceinline__ void gemm_phase(PG8_LAS unsigned char* lds, const Gemm g, const Sched& S, const Epi& E) {
    const int tid = threadIdx.x, wid = __builtin_amdgcn_readfirstlane(tid >> 6), lane = tid & 63, wr = wid >> 2, wc = wid & 3, fr = lane & 15, fq = lane >> 4;
    const int K = g.K, nt = K / BK;
    unsigned voffA[2], voffB[2];
#pragma unroll
    for (int i = 0; i < 2; ++i) { int R, C; stage_rc(tid * 16 + i * 8192, R, C); const int Rb = Epi::PERM ? ((R & ~31) + perm32(R & 31)) : R;
        voffA[i] = (unsigned)(R * K + C) * 2u; voffB[i] = (unsigned)(Rb * K + C) * 2u; }
    const size_t kstep = (size_t)(BK * 2);
    const size_t hstep = (size_t)HALF * K * 2;
    const size_t tstep = 2 * hstep;
    const unsigned ldsw = (unsigned)wid * 1024u;
    const int aoff = lds_byte(wr * 64 + fr, fq * 8), boff = lds_byte(wc * 32 + fr, fq * 8);
#define PG8_SA(b, h) (((b) * 2 + (h)) * HTB)
#define PG8_SB(b, h) ((4 + (b) * 2 + (h)) * HTB)
#define PG8_STAGE(bufoff, gbase, voff) do { _Pragma("unroll") for (int _i = 0; _i < 2; ++_i) \
        __builtin_amdgcn_global_load_lds((const unsigned*)((const char*)(gbase) + (voff)[_i]), (PG8_LAS unsigned*)(lds + (bufoff) + ldsw + _i * 8192), 16, 0, 0); } while (0)
#define PG8_LDA(dst, b, h) do { _Pragma("unroll") for (int m = 0; m < 4; ++m) _Pragma("unroll") for (int k = 0; k < 2; ++k) dst[m][k] = *(const PG8_LAS bf16x8*)(lds + PG8_SA(b, h) + aoff + m * 2048 + k * 1024); } while (0)
#define PG8_LDB(dst, b, h) do { _Pragma("unroll") for (int n = 0; n < 2; ++n) _Pragma("unroll") for (int k = 0; k < 2; ++k) dst[n][k] = *(const PG8_LAS bf16x8*)(lds + PG8_SB(b, h) + boff + n * 2048 + k * 1024); } while (0)
#define PG8_MMA(ai, bj, At, Bt) do { __builtin_amdgcn_s_setprio(1); _Pragma("unroll") for (int m = 0; m < 4; ++m) _Pragma("unroll") for (int n = 0; n < 2; ++n) _Pragma("unroll") for (int k = 0; k < 2; ++k) \
        acc[ai][bj][m][n] = __builtin_amdgcn_mfma_f32_16x16x32_bf16(Bt[n][k], At[m][k], acc[ai][bj][m][n], 0, 0, 0); __builtin_amdgcn_s_setprio(0); } while (0)
#define PG8_WAIT_V(n) asm volatile("s_waitcnt vmcnt(" #n ")" ::: "memory")
#define PG8_WAIT_L(n) asm volatile("s_waitcnt lgkmcnt(" #n ")" ::: "memory")
#define PG8_BAR __builtin_amdgcn_s_barrier()
#define PG8_SCHED __builtin_amdgcn_sched_barrier(0)
    Unit cur, nxt; int ui = 0;
    if (!S.next(0, cur)) return;
    f32x4 acc[2][2][4][2];
#pragma unroll
    for (int a = 0; a < 2; ++a)
#pragma unroll
        for (int b = 0; b < 2; ++b)
#pragma unroll
            for (int m = 0; m < 4; ++m)
#pragma unroll
                for (int n = 0; n < 2; ++n) acc[a][b][m][n] = (f32x4){0.f, 0.f, 0.f, 0.f};
    bf16x8 At[4][2], B0[2][2], B1[2][2];
    const char* cA = (const char*)g.A + (size_t)cur.pm * tstep; const char* cB = (const char*)g.Bt + (size_t)cur.pn * tstep;
    S.a_ready(cur);
    if constexpr (SP2) {
        PG8_STAGE(PG8_SB(0, 0), cB, voffB); PG8_STAGE(PG8_SB(0, 1), cB + hstep, voffB); PG8_STAGE(PG8_SA(0, 0), cA, voffA); PG8_STAGE(PG8_SA(0, 1), cA + hstep, voffA);
        if (wr == 1) PG8_BAR;
        PG8_WAIT_V(2); PG8_BAR;
        PG8_STAGE(PG8_SB(1, 0), cB + kstep, voffB); PG8_STAGE(PG8_SA(1, 0), cA + kstep, voffA); PG8_STAGE(PG8_SB(1, 1), cB + hstep + kstep, voffB);
        PG8_WAIT_V(6); PG8_BAR;
    } else {
        PG8_STAGE(PG8_SB(0, 0), cB, voffB); PG8_STAGE(PG8_SA(0, 0), cA, voffA); PG8_STAGE(PG8_SB(0, 1), cB + hstep, voffB); PG8_STAGE(PG8_SA(0, 1), cA + hstep, voffA);
        if (wr == 1) PG8_BAR;
        PG8_WAIT_V(4); PG8_BAR;
        PG8_STAGE(PG8_SB(1, 0), cB + kstep, voffB); PG8_STAGE(PG8_SA(1, 0), cA + kstep, voffA); PG8_STAGE(PG8_SB(1, 1), cB + hstep + kstep, voffB);
        PG8_WAIT_V(6); PG8_BAR;
    }
    for (;;) {
        const bool has_next = S.next(ui + 1, nxt);
        const char* nA = has_next ? (const char*)g.A + (size_t)nxt.pm * tstep : cA; const char* nB = has_next ? (const char*)g.Bt + (size_t)nxt.pn * tstep : cB;
        for (int t = 0; t < nt; t += 2) {
            const bool last = (t == nt - 2);
            const char* a1 = cA + (size_t)(t + 1) * kstep;
            const char* a2 = last ? nA : cA + (size_t)(t + 2) * kstep; const char* b2 = last ? nB : cB + (size_t)(t + 2) * kstep;
            const char* a3 = a2 + kstep; const char* b3 = b2 + kstep;
            if (last && has_next) S.a_ready(nxt);
            if constexpr (SP2) {
            PG8_LDB(B0, 0, 0); PG8_LDB(B1, 0, 1); PG8_SCHED; PG8_LDA(At, 0, 0); PG8_STAGE(PG8_SA(1, 1), a1 + hstep, voffA);
            PG8_WAIT_V(8); PG8_WAIT_L(0); PG8_BAR; PG8_MMA(0, 0, At, B0); PG8_MMA(0, 1, At, B1); PG8_BAR; PG8_SCHED;
            PG8_LDA(At, 0, 1); PG8_STAGE(PG8_SB(0, 0), b2, voffB); PG8_STAGE(PG8_SB(0, 1), b2 + hstep, voffB); PG8_STAGE(PG8_SA(0, 0), a2, voffA);
            PG8_WAIT_V(8); PG8_WAIT_L(0); PG8_BAR; PG8_MMA(1, 0, At, B0); PG8_MMA(1, 1, At, B1); PG8_BAR; PG8_SCHED;
            PG8_LDB(B0, 1, 0); PG8_LDB(B1, 1, 1); PG8_SCHED; PG8_LDA(At, 1, 0); PG8_STAGE(PG8_SA(0, 1), a2 + hstep, voffA);
            PG8_WAIT_V(8); PG8_WAIT_L(0); PG8_BAR; PG8_MMA(0, 0, At, B0); PG8_MMA(0, 1, At, B1); PG8_BAR; PG8_SCHED;
            PG8_LDA(At, 1, 1); PG8_STAGE(PG8_SB(1, 0), b3, voffB); PG8_STAGE(PG8_SB(1, 1), b3 + hstep, voffB); PG8_STAGE(PG8_SA(1, 0), a3, voffA);
            PG8_WAIT_V(8); PG8_WAIT_L(0); PG8_BAR; PG8_MMA(1, 0, At, B0); PG8_MMA(1, 1, At, B1); PG8_BAR; PG8_SCHED;
            } else {
            PG8_LDB(B0, 0, 0); PG8_SCHED; PG8_LDA(At, 0, 0); PG8_STAGE(PG8_SA(1, 1), a1 + hstep, voffA);
            PG8_WAIT_L(8); PG8_BAR; PG8_WAIT_L(0); PG8_MMA(0, 0, At, B0); PG8_BAR; PG8_SCHED;
            PG8_LDB(B1, 0, 1); PG8_STAGE(PG8_SB(0, 0), b2, voffB);
            PG8_BAR; PG8_WAIT_L(0); PG8_MMA(0, 1, At, B1); PG8_BAR;
            PG8_LDA(At, 0, 1); PG8_STAGE(PG8_SA(0, 0), a2, voffA);
            PG8_BAR; PG8_WAIT_L(0); PG8_MMA(1, 0, At, B0); PG8_BAR; PG8_SCHED;
            PG8_STAGE(PG8_SB(0, 1), b2 + hstep, voffB);
            PG8_WAIT_V(6); PG8_BAR; PG8_MMA(1, 1, At, B1); PG8_BAR;
            PG8_LDB(B0, 1, 0); PG8_SCHED; PG8_LDA(At, 1, 0); PG8_STAGE(PG8_SA(0, 1), a2 + hstep, voffA);
            PG8_WAIT_L(8); PG8_BAR; PG8_WAIT_L(0); PG8_MMA(0, 0, At, B0); PG8_BAR; PG8_SCHED;
            PG8_LDB(B1, 1, 1); PG8_STAGE(PG8_SB(1, 0), b3, voffB);
            PG8_BAR; PG8_WAIT_L(0); PG8_MMA(0, 1, At, B1); PG8_BAR;
            PG8_LDA(At, 1, 1); PG8_STAGE(PG8_SA(1, 0), a3, voffA);
            PG8_BAR; PG8_WAIT_L(0); PG8_MMA(1, 0, At, B0); PG8_BAR; PG8_SCHED;
            PG8_STAGE(PG8_SB(1, 1), b3 + hstep, voffB);
            PG8_WAIT_V(6); PG8_BAR; PG8_MMA(1, 1, At, B1); PG8_BAR;
            }
        }
        if constexpr (ALIGN_EPI) { if (wr == 0) PG8_BAR; }
        if constexpr (!Epi::AFTER_DRAIN) { E(acc, cur, wr, wc, fr, fq); S.done(cur); }
        if (!has_next) break;
#pragma unroll
        for (int a = 0; a < 2; ++a)
#pragma unroll
            for (int b = 0; b < 2; ++b)
#pragma unroll
                for (int m = 0; m < 4; ++m)
#pragma unroll
                    for (int n = 0; n < 2; ++n) acc[a][b][m][n] = (f32x4){0.f, 0.f, 0.f, 0.f};
        cur = nxt; cA = nA; cB = nB; ++ui;
        if constexpr (ALIGN_EPI) { if (wr == 1) PG8_BAR; }
    }
    PG8_WAIT_V(0);
    if constexpr (!ALIGN_EPI) { if (wr == 0) PG8_BAR; }
    PG8_BAR;
    if constexpr (Epi::AFTER_DRAIN) { E.fused(acc, cur, wr, wc, fr, fq, lds, wid, lane); S.done(cur); }
#undef PG8_SA
#undef PG8_SB
#undef PG8_STAGE
#undef PG8_LDA
#undef PG8_LDB
#undef PG8_MMA
#undef PG8_WAIT_V
#undef PG8_WAIT_L
#undef PG8_BAR
#undef PG8_SCHED
}
}
#define GAS __attribute__((address_space(1)))
#define LAS __attribute__((address_space(3)))
typedef unsigned short bf16;
typedef unsigned v4u __attribute__((ext_vector_type(4)));
typedef float f32x4 __attribute__((ext_vector_type(4)));
typedef short bf16x8 __attribute__((ext_vector_type(8)));
typedef GAS unsigned gu32;
typedef GAS unsigned long long gu64;
#define RLX_AGENT __ATOMIC_RELAXED, __HIP_MEMORY_SCOPE_AGENT
#define LDS_WAIT() asm volatile("s_waitcnt lgkmcnt(0)" ::: "memory")
#define VM_WAIT() asm volatile("s_waitcnt vmcnt(0)" ::: "memory")
__device__ __forceinline__ unsigned long long rt() { return __builtin_amdgcn_s_memrealtime(); }
__device__ __forceinline__ unsigned f2bf(float f) { unsigned u = __builtin_bit_cast(unsigned, f); return (u + 0x7fffu + ((u >> 16) & 1u)) >> 16; }
__device__ __forceinline__ unsigned pk2(float lo, float hi) { return f2bf(lo) | (f2bf(hi) << 16); }

#define XB_TMO      128
#define XB_XCNT(j)  (256  + 64 * (j))
#define XB_XSUB(j)  (1280 + 64 * (j))
#define XB_XGEN(j)  (2304 + 64 * (j))
#define XB_TOP      3328
#define XB_TOPGEN   3392
#define XCD_BAR_WORDS 3456
#define XB_SPIN_CAP (1u << 18)

__device__ __forceinline__ unsigned xb_ld(unsigned* p)              { return __hip_atomic_load(p, __ATOMIC_RELAXED, __HIP_MEMORY_SCOPE_AGENT); }
__device__ __forceinline__ unsigned xb_add(unsigned* p, unsigned v) { return __hip_atomic_fetch_add(p, v, __ATOMIC_RELAXED, __HIP_MEMORY_SCOPE_AGENT); }
__device__ __forceinline__ unsigned xb_xcc_id() { return (unsigned)__builtin_amdgcn_s_getreg((3 << 11) | 20) & 0xFu; }
#define XB_SPIN(cond, bar) do { unsigned _sp = 0; while (cond) { __builtin_amdgcn_s_sleep(1); \
    if ((++_sp & 255u) == 0u) { if (xb_ld(&(bar)[XB_TMO])) break; if (_sp > XB_SPIN_CAP) { atomicAdd(&(bar)[XB_TMO], 1u); break; } } } } while (0)

struct XcdBarrier {
    unsigned* bar; unsigned x;
    volatile LAS unsigned* st;
};

__device__ __forceinline__ XcdBarrier xcd_barrier_post(unsigned* bar, volatile LAS unsigned* st) {
    XcdBarrier b; b.bar = bar; b.x = xb_xcc_id(); b.st = st;
    if (threadIdx.x == 0) (void)xb_add(&bar[XB_XCNT(b.x)], 1u);
    return b;
}
__device__ __forceinline__ void xcd_barrier_complete(unsigned* bar, unsigned x, unsigned& nloc, unsigned& nx) {
    const unsigned G = gridDim.x * gridDim.y * gridDim.z;
    unsigned sum, cnt, mine, sp = 0u;
    for (;;) {
        sum = 0u; cnt = 0u; mine = 0u;
#pragma unroll
        for (unsigned j = 0; j < 16; ++j) { const unsigned c = xb_ld(&bar[XB_XCNT(j)]); sum += c; cnt += (c > 0u) ? 1u : 0u; mine = (j == x) ? c : mine; }
        if (sum == G) break;
        __builtin_amdgcn_s_sleep(1);
        if ((++sp & 255u) == 0u) { if (xb_ld(&bar[XB_TMO])) break; if (sp > XB_SPIN_CAP) { atomicAdd(&bar[XB_TMO], 1u); break; } }
    }
    nloc = mine > 0u ? mine : 1u; nx = cnt > 0u ? cnt : 1u;
}

__device__ __forceinline__ void xcd_barrier(const XcdBarrier& b) {
    asm volatile("s_waitcnt vmcnt(0)" ::: "memory");
    __syncthreads();
    if (threadIdx.x == 0) {
        unsigned* bar = b.bar;
        __builtin_amdgcn_s_waitcnt(0);
        unsigned nloc = b.st[0], nx = b.st[1];
        if (nloc == 0u) { xcd_barrier_complete(bar, b.x, nloc, nx); b.st[0] = nloc; b.st[1] = nx; }
        const unsigned old = xb_add(&bar[XB_XSUB(b.x)], 1u);
        const unsigned gen = old / nloc;
        if (old + 1u == (gen + 1u) * nloc) {
            __builtin_amdgcn_fence(__ATOMIC_RELEASE, "agent");
            asm volatile("s_waitcnt vmcnt(0)" ::: "memory");
            const unsigned og = xb_add(&bar[XB_TOP], 1u);
            const unsigned tg = og / nx;
            if (og + 1u == (tg + 1u) * nx) xb_add(&bar[XB_TOPGEN], 1u);
            else XB_SPIN(xb_ld(&bar[XB_TOPGEN]) == tg, bar);
            __builtin_amdgcn_fence(__ATOMIC_ACQUIRE, "agent");
            xb_add(&bar[XB_XGEN(b.x)], 1u);
            asm volatile("s_waitcnt vmcnt(0)" ::: "memory");
        } else {
            XB_SPIN(xb_ld(&bar[XB_XGEN(b.x)]) == gen, bar);
            __builtin_amdgcn_fence(__ATOMIC_ACQUIRE, "agent");
            asm volatile("s_waitcnt vmcnt(0)" ::: "memory");
        }
    }
    __syncthreads();
}

constexpr size_t MiB = 1u << 20;
constexpr size_t WS_CTL = 0, CTL_ZERO_BYTES = 1 * MiB;
constexpr int CW_BAR = 4096;
constexpr size_t WS_MOD = 1 * MiB;
constexpr size_t WS_KMEAN = 1 * MiB + 256 * 1024;
constexpr size_t WS_SSMT = 2 * MiB;
constexpr size_t WS_WIN = 28 * MiB, WS_WGLU = 36 * MiB, WS_WAO = 38 * MiB, WS_WOUT = 39 * MiB, WS_WGU = 41 * MiB, WS_WDN = 52 * MiB;
constexpr size_t WS_HN = 58 * MiB;
constexpr size_t WS_UG = 122 * MiB, WS_QH = 154 * MiB, WS_KH = 186 * MiB, WS_VH = 218 * MiB, WS_VT = 250 * MiB;
constexpr size_t WS_G = 282 * MiB;
constexpr size_t WS_Z = 410 * MiB, WS_O = 442 * MiB;
constexpr size_t WS_T1 = 122 * MiB;
constexpr size_t WS_MG = 186 * MiB;
constexpr size_t WS_H = 122 * MiB;
constexpr size_t WS_Y1 = 282 * MiB;
constexpr size_t WS_Y2 = 298 * MiB;
constexpr size_t WS_END = 474 * MiB;

constexpr int RING_OFF = 0, RING_BYTES = 131072;
constexpr int LDSCTL_OFF = RING_BYTES, MISC_OFF = LDSCTL_OFF + 320;
constexpr int LDS_BYTES = 147456;
constexpr int NWAVES = 8, NTHREADS = 512;

__device__ __forceinline__ float bf2f(bf16 b) { return __uint_as_float(((unsigned)b) << 16); }
__device__ __forceinline__ float wave_sum(float v) {
#pragma unroll
    for (int o = 1; o < 64; o <<= 1) v += __shfl_xor(v, o);
    return v;
}
__device__ __forceinline__ float wave_max(float v) {
#pragma unroll
    for (int o = 1; o < 64; o <<= 1) v = fmaxf(v, __shfl_xor(v, o));
    return v;
}

struct Frame {
    LAS unsigned char* lds;
    int tid, lane, wave, vcu, G;
    const float* in[24]; float* out; unsigned char* ws;
};
enum { I_X = 0, I_C, I_WADA, I_BADA, I_GPRE_MIX, I_GPOST_MIX, I_WIN, I_ARE, I_AIM, I_LOGDT, I_BRE, I_BIM, I_CRE, I_CIM, I_SD, I_WGLUA, I_WGLUB, I_WAO, I_WOUT, I_GPRE_FFN, I_GPOST_FFN, I_WGATE, I_WUP, I_WDOWN };

__device__ __forceinline__ void transpose_item(const float* W, int K, int N, bf16* WT, int k0, int n0, int drow0, LAS float* scr, int lane) {
#pragma unroll 8
    for (int i = 0; i < 32; ++i) { const int kk = 2 * i + (lane >> 5); scr[kk * 33 + (lane & 31)] = W[(size_t)(k0 + kk) * N + n0 + (lane & 31)]; }
    LDS_WAIT(); asm volatile("" ::: "memory");
    const int c = lane & 7;
#pragma unroll
    for (int j = 0; j < 4; ++j) { const int n = (lane >> 3) + 8 * j; const LAS float* s = scr + (8 * c) * 33 + n;
        v4u o; o.x = pk2(s[0 * 33], s[1 * 33]); o.y = pk2(s[2 * 33], s[3 * 33]); o.z = pk2(s[4 * 33], s[5 * 33]); o.w = pk2(s[6 * 33], s[7 * 33]);
        *(GAS v4u*)(WT + (size_t)(drow0 + n) * K + k0 + 8 * c) = o; }
    LDS_WAIT(); asm volatile("" ::: "memory");
}
__device__ __forceinline__ int ilv_row(int n0, int which) { return 256 * (n0 >> 7) + 128 * which + (n0 & 127); }

__device__ __forceinline__ void p0a_weights_mod(Frame& F) {
    LAS float* scr = (LAS float*)(F.lds + RING_OFF + F.wave * 16384);
    const int gw = F.vcu * NWAVES + F.wave, NGW = F.G * NWAVES;
    bf16* WIN = (bf16*)(F.ws + WS_WIN); bf16* WGLU = (bf16*)(F.ws + WS_WGLU); bf16* WAO = (bf16*)(F.ws + WS_WAO); bf16* WOUT = (bf16*)(F.ws + WS_WOUT); bf16* WGU = (bf16*)(F.ws + WS_WGU); bf16* WDN = (bf16*)(F.ws + WS_WDN);
    constexpr int I_IN = 16 * 128, I_GA = 8 * 32, I_AO = 8 * 32, I_OUT = 16 * 32, I_GT = 16 * 88, I_DN = 44 * 32;
    constexpr int NITEMS = I_IN + 2 * I_GA + I_AO + I_OUT + 2 * I_GT + I_DN;
    for (int it = gw; it < NITEMS; it += NGW) {
        int r = it;
        if (r < I_IN) { const int kb = r / 128, nb = r % 128; transpose_item(F.in[I_WIN], 1024, 4096, WIN, 64 * kb, 32 * nb, 32 * nb, scr, F.lane); continue; } r -= I_IN;
        if (r < I_GA) { const int kb = r / 32, nb = r % 32; transpose_item(F.in[I_WGLUA], 512, 1024, WGLU, 64 * kb, 32 * nb, ilv_row(32 * nb, 0), scr, F.lane); continue; } r -= I_GA;
        if (r < I_GA) { const int kb = r / 32, nb = r % 32; transpose_item(F.in[I_WGLUB], 512, 1024, WGLU, 64 * kb, 32 * nb, ilv_row(32 * nb, 1), scr, F.lane); continue; } r -= I_GA;
        if (r < I_AO) { const int kb = r / 32, nb = r % 32; transpose_item(F.in[I_WAO], 512, 1024, WAO, 64 * kb, 32 * nb, 32 * nb, scr, F.lane); continue; } r -= I_AO;
        if (r < I_OUT) { const int kb = r / 32, nb = r % 32; transpose_item(F.in[I_WOUT], 1024, 1024, WOUT, 64 * kb, 32 * nb, 32 * nb, scr, F.lane); continue; } r -= I_OUT;
        if (r < I_GT) { const int kb = r / 88, nb = r % 88; transpose_item(F.in[I_WGATE], 1024, 2816, WGU, 64 * kb, 32 * nb, ilv_row(32 * nb, 0), scr, F.lane); continue; } r -= I_GT;
        if (r < I_GT) { const int kb = r / 88, nb = r % 88; transpose_item(F.in[I_WUP], 1024, 2816, WGU, 64 * kb, 32 * nb, ilv_row(32 * nb, 1), scr, F.lane); continue; } r -= I_GT;
        { const int kb = r / 32, nb = r % 32; transpose_item(F.in[I_WDOWN], 2816, 1024, WDN, 64 * kb, 32 * nb, 32 * nb, scr, F.lane); }
    }
    __syncthreads();
    if (F.vcu < 96) {
        LAS float* cact = (LAS float*)(F.lds + RING_OFF);
        LAS float* red = cact + 4096;
        for (int i = F.tid; i < 4096; i += NTHREADS) { const float cv = F.in[I_C][i]; cact[i] = cv / (1.0f + __expf(-cv)); }
        __syncthreads();
        const float* wada = F.in[I_WADA]; float* mod = (float*)(F.ws + WS_MOD);
        for (int it = F.vcu; it < 96; it += F.G) {
            const int col = F.tid & 63, ks = F.tid >> 6, n = it * 64 + col;
            float a0 = 0.f, a1 = 0.f, a2 = 0.f, a3 = 0.f;
#pragma unroll 4
            for (int k = ks * 128; k < ks * 128 + 128; ++k) { const float w = wada[(size_t)k * 6144 + n]; a0 += cact[k] * w; a1 += cact[1024 + k] * w; a2 += cact[2048 + k] * w; a3 += cact[3072 + k] * w; }
            red[(ks * 4 + 0) * 64 + col] = a0; red[(ks * 4 + 1) * 64 + col] = a1; red[(ks * 4 + 2) * 64 + col] = a2; red[(ks * 4 + 3) * 64 + col] = a3;
            __syncthreads();
            if (F.tid < 256) { const int b = F.tid >> 6, c = F.tid & 63; float s = F.in[I_BADA][it * 64 + c];
#pragma unroll
                for (int q = 0; q < 8; ++q) s += red[(q * 4 + b) * 64 + c];
                mod[b * 6144 + it * 64 + c] = s; }
            __syncthreads();
        }
    }
}

__device__ __forceinline__ void adaln_row(int lane, const float* xrow, const float* gw, const float* sc, const float* sh, bf16* orow) {
    const GAS f32x4* xr = (const GAS f32x4*)xrow + lane;
    f32x4 v[4]; float s = 0.f;
#pragma unroll
    for (int j = 0; j < 4; ++j) { v[j] = xr[64 * j]; s += (v[j].x * v[j].x + v[j].y * v[j].y) + (v[j].z * v[j].z + v[j].w * v[j].w); }
    const float rstd = 1.0f / sqrtf(wave_sum(s) * (1.0f / 1024.0f) + NORM_EPS);
    GAS unsigned long long* o8 = (GAS unsigned long long*)orow + lane;
#pragma unroll
    for (int j = 0; j < 4; ++j) { const f32x4 g4 = ((const GAS f32x4*)gw + lane)[64 * j], sc4 = ((const GAS f32x4*)sc + lane)[64 * j], sh4 = ((const GAS f32x4*)sh + lane)[64 * j];
        const f32x4 o = v[j] * rstd * g4 * (sc4 + 1.0f) + sh4;
        o8[64 * j] = (unsigned long long)pk2(o.x, o.y) | ((unsigned long long)pk2(o.z, o.w) << 32); }
}
__device__ __forceinline__ void p0b_hn(Frame& F) {
    const int gw = F.vcu * NWAVES + F.wave, NGW = F.G * NWAVES;
    const float* mod = (const float*)(F.ws + WS_MOD); bf16* HN = (bf16*)(F.ws + WS_HN);
    for (int m = gw; m < MT; m += NGW) { const int b = m >> 13;
        adaln_row(F.lane, F.in[I_X] + (size_t)m * 1024, F.in[I_GPRE_MIX], mod + b * 6144 + 1024, mod + b * 6144, HN + (size_t)m * 1024); }
}
__device__ __forceinline__ void norm_pass1(Frame& F) {
    const int gw = F.vcu * NWAVES + F.wave, NGW = F.G * NWAVES, lane = F.lane;
    const float* mod = (const float*)(F.ws + WS_MOD); bf16* HN2 = (bf16*)(F.ws + WS_HN); const float* Y = (const float*)(F.ws + WS_Y1);
    for (int m = gw; m < MT; m += NGW) { const int b = m >> 13;
        const GAS f32x4* yr = (const GAS f32x4*)(Y + (size_t)m * 1024) + lane; const GAS f32x4* xr = (const GAS f32x4*)(F.in[I_X] + (size_t)m * 1024) + lane;
        f32x4 y[4], x1[4]; float s = 0.f;
#pragma unroll
        for (int j = 0; j < 4; ++j) { y[j] = yr[64 * j]; s += (y[j].x * y[j].x + y[j].y * y[j].y) + (y[j].z * y[j].z + y[j].w * y[j].w); }
        const float rstd = 1.0f / sqrtf(wave_sum(s) * (1.0f / 1024.0f) + NORM_EPS); float s2 = 0.f;
#pragma unroll
        for (int j = 0; j < 4; ++j) { const f32x4 g4 = ((const GAS f32x4*)F.in[I_GPOST_MIX] + lane)[64 * j], gt4 = ((const GAS f32x4*)(mod + b * 6144 + 2048) + lane)[64 * j];
            x1[j] = xr[64 * j] + gt4 * (y[j] * rstd * g4); ((GAS f32x4*)(F.out + (size_t)m * 1024) + lane)[64 * j] = x1[j];
            s2 += (x1[j].x * x1[j].x + x1[j].y * x1[j].y) + (x1[j].z * x1[j].z + x1[j].w * x1[j].w); }
        const float rstd2 = 1.0f / sqrtf(wave_sum(s2) * (1.0f / 1024.0f) + NORM_EPS);
        GAS unsigned long long* o8 = (GAS unsigned long long*)(HN2 + (size_t)m * 1024) + lane;
#pragma unroll
        for (int j = 0; j < 4; ++j) { const f32x4 g4 = ((const GAS f32x4*)F.in[I_GPRE_FFN] + lane)[64 * j], sc4 = ((const GAS f32x4*)(mod + b * 6144 + 4096) + lane)[64 * j], sh4 = ((const GAS f32x4*)(mod + b * 6144 + 3072) + lane)[64 * j];
            const f32x4 o = x1[j] * rstd2 * g4 * (sc4 + 1.0f) + sh4;
            o8[64 * j] = (unsigned long long)pk2(o.x, o.y) | ((unsigned long long)pk2(o.z, o.w) << 32); }
    }
}
__device__ __forceinline__ void norm_pass2(Frame& F) {
    const int gw = F.vcu * NWAVES + F.wave, NGW = F.G * NWAVES, lane = F.lane;
    const float* mod = (const float*)(F.ws + WS_MOD); const float* Y = (const float*)(F.ws + WS_Y2);
    for (int m = gw; m < MT; m += NGW) { const int b = m >> 13;
        const GAS f32x4* yr = (const GAS f32x4*)(Y + (size_t)m * 1024) + lane; GAS f32x4* xr = (GAS f32x4*)(F.out + (size_t)m * 1024) + lane;
        f32x4 y[4]; float s = 0.f;
#pragma unroll
        for (int j = 0; j < 4; ++j) { y[j] = yr[64 * j]; s += (y[j].x * y[j].x + y[j].y * y[j].y) + (y[j].z * y[j].z + y[j].w * y[j].w); }
        const float rstd = 1.0f / sqrtf(wave_sum(s) * (1.0f / 1024.0f) + NORM_EPS);
#pragma unroll
        for (int j = 0; j < 4; ++j) { const f32x4 g4 = ((const GAS f32x4*)F.in[I_GPOST_FFN] + lane)[64 * j], gt4 = ((const GAS f32x4*)(mod + b * 6144 + 5120) + lane)[64 * j];
            xr[64 * j] = xr[64 * j] + gt4 * (y[j] * rstd * g4); }
    }
}

__device__ __forceinline__ void kmean_phase(Frame& F) {
    const int gw = F.vcu * NWAVES + F.wave, NGW = F.G * NWAVES;
    const bf16* KH = (const bf16*)(F.ws + WS_KH); float* KM = (float*)(F.ws + WS_KMEAN);
    for (int u = gw; u < NB * NH * NBLK; u += NGW) {
        const bf16* kp = KH + (size_t)u * MBLK * 64 + F.lane; float s = 0.f;
#pragma unroll 8
        for (int k = 0; k < MBLK; ++k) s += bf2f(kp[k * 64]);
        KM[u * 64 + F.lane] = s * (1.0f / 256.0f);
    }
}

__device__ __forceinline__ float gelu_tanh(float y) {
    const float a = 0.7978845608028654f * (y + 0.044715f * y * y * y);
    const float e = __builtin_amdgcn_exp2f(2.0f * LOG2E * a);
    const float t = 1.0f - 2.0f * __builtin_amdgcn_rcpf(e + 1.0f);
    return 0.5f * y * (1.0f + t);
}
__device__ __forceinline__ void ssm_simple_phase(Frame& F) {
    const int gw = F.vcu * NWAVES + F.wave, NGW = F.G * NWAVES, lane = F.lane;
    LAS float* Cl = (LAS float*)(F.lds + RING_OFF + F.wave * 16384);
    LAS float* xs = Cl + 16 * 132;
    LAS float* us = xs + 4 * 132;
    const bf16* UG = (const bf16*)(F.ws + WS_UG); bf16* Z = (bf16*)(F.ws + WS_Z);
    for (int unit = gw; unit < NB * NGRP; unit += NGW) {
        const int b = unit >> 5, g = unit & 31, p = lane;
        const float dt = expf(F.in[I_LOGDT][g]), are = F.in[I_ARE][g * 64 + p], aim = F.in[I_AIM][g * 64 + p];
        const float mag = expf(dt * are), abr = mag * cosf(dt * aim), abi = mag * sinf(dt * aim);
        const float den = are * are + aim * aim, nr = abr - 1.0f, cor = (nr * are + abi * aim) / den, coi = (abi * are - nr * aim) / den;
        float bbr[16], bbi[16];
#pragma unroll
        for (int c = 0; c < 16; ++c) { const float br = F.in[I_BRE][(g * 64 + p) * 16 + c], bi = F.in[I_BIM][(g * 64 + p) * 16 + c]; bbr[c] = cor * br - coi * bi; bbi[c] = cor * bi + coi * br; }
#pragma unroll
        for (int c = 0; c < 16; ++c) { Cl[c * 132 + p] = F.in[I_CRE][(g * 16 + c) * 64 + p]; Cl[c * 132 + 64 + p] = -F.in[I_CIM][(g * 16 + c) * 64 + p]; }
        const float dsk = F.in[I_SD][g * 16 + (lane & 15)];
        float xr = 0.f, xi = 0.f;
        const bf16* up = UG + (size_t)(b * 32 + g) * SEQ * 16;
        const int tt = lane >> 4, c = lane & 15;
        for (int t0 = 0; t0 < SEQ; t0 += 4) {
            const float uf = bf2f(up[(size_t)t0 * 16 + lane]);
            us[lane] = uf;
            asm volatile("s_waitcnt lgkmcnt(0)" ::: "memory");
#pragma unroll
            for (int q = 0; q < 4; ++q) {
                float bur = 0.f, bui = 0.f;
#pragma unroll
                for (int cc = 0; cc < 16; ++cc) { const float uv = us[q * 16 + cc]; bur += bbr[cc] * uv; bui += bbi[cc] * uv; }
                const float nxr = abr * xr - abi * xi + bur, nxi = abr * xi + abi * xr + bui; xr = nxr; xi = nxi;
                xs[q * 132 + p] = xr; xs[q * 132 + 64 + p] = xi;
            }
            asm volatile("s_waitcnt lgkmcnt(0)" ::: "memory");
            float y = 0.f;
#pragma unroll 8
            for (int q = 0; q < 128; q += 4) { const f32x4 cv = *(const LAS f32x4*)(Cl + c * 132 + q), xv = *(const LAS f32x4*)(xs + tt * 132 + q); y += (cv.x * xv.x + cv.y * xv.y) + (cv.z * xv.z + cv.w * xv.w); }
            y += dsk * uf;
            Z[(size_t)(b * SEQ + t0 + tt) * 512 + g * 16 + c] = (bf16)f2bf(gelu_tanh(y));
            asm volatile("s_waitcnt lgkmcnt(0)" ::: "memory");
        }
    }
}

__device__ __forceinline__ void attn_simple_phase(Frame& F) {
    const int gw = F.vcu * NWAVES + F.wave, NGW = F.G * NWAVES, lane = F.lane;
    LAS float* qs = (LAS float*)(F.lds + RING_OFF + F.wave * 8192);
    LAS float* lg = qs + 64;
    const bf16* QH = (const bf16*)(F.ws + WS_QH); const bf16* KH = (const bf16*)(F.ws + WS_KH); const bf16* VH = (const bf16*)(F.ws + WS_VH);
    const float* KM = (const float*)(F.ws + WS_KMEAN); bf16* O = (bf16*)(F.ws + WS_O);
    const float NEG = -INFINITY;
    for (int unit = gw; unit < NB * NH * SEQ; unit += NGW) {
        const int t = unit & 8191, bh = unit >> 13, h = bh & 7, b = bh >> 3, qb = t >> 8;
        const float sl2 = exp2f(-(float)(h + 1)) * LOG2E;
        qs[lane] = bf2f(QH[((size_t)bh * SEQ + t) * 64 + lane]);
        asm volatile("s_waitcnt lgkmcnt(0)" ::: "memory");
        float gv = NEG;
        if (lane < qb) { const float* km = KM + ((size_t)bh * 32 + lane) * 64; float s = 0.f;
#pragma unroll 8
            for (int d = 0; d < 64; ++d) s += qs[d] * km[d];
            gv = s; }
        const int nsel = qb < 3 ? qb : 3; int sel0 = 0, sel1 = 0, sel2 = 0;
#pragma unroll
        for (int k = 0; k < 3; ++k) if (k < nsel) {
            const float m = wave_max(gv); const unsigned long long mask = __ballot(gv == m); const int idx = __ffsll((long long)mask) - 1;
            if (k == 0) sel0 = idx; else if (k == 1) sel1 = idx; else sel2 = idx;
            if (lane == idx) gv = NEG; }
        const int nown = t - qb * 256 + 1, nkeys = nsel * 256 + nown;
        const bf16* Kb = KH + (size_t)bh * SEQ * 64; const bf16* Vb = VH + (size_t)bh * SEQ * 64;
        float mx = NEG;
        for (int i = 0; i * 64 < nkeys; ++i) {
            const int kk = i * 64 + lane; const bool valid = kk < nkeys; const int seg = kk >> 8;
            const int blk = (seg < nsel) ? (seg == 0 ? sel0 : (seg == 1 ? sel1 : sel2)) : qb;
            const int pos = valid ? blk * 256 + (kk & 255) : t;
            const GAS v4u* kr = (const GAS v4u*)(Kb + (size_t)pos * 64); float dot = 0.f;
#pragma unroll
            for (int j = 0; j < 8; ++j) { const v4u w = kr[j];
                dot += qs[8 * j + 0] * __uint_as_float(w.x << 16) + qs[8 * j + 1] * __uint_as_float(w.x & 0xffff0000u) + qs[8 * j + 2] * __uint_as_float(w.y << 16) + qs[8 * j + 3] * __uint_as_float(w.y & 0xffff0000u)
                     + qs[8 * j + 4] * __uint_as_float(w.z << 16) + qs[8 * j + 5] * __uint_as_float(w.z & 0xffff0000u) + qs[8 * j + 6] * __uint_as_float(w.w << 16) + qs[8 * j + 7] * __uint_as_float(w.w & 0xffff0000u); }
            const float l = valid ? dot - sl2 * (float)(t - pos) : NEG;
            lg[kk] = l; mx = fmaxf(mx, l);
        }
        mx = wave_max(mx);
        asm volatile("s_waitcnt lgkmcnt(0)" ::: "memory");
        float sum = 0.f;
        for (int i = 0; i * 64 < nkeys; ++i) { const int kk = i * 64 + lane; const float pv = __builtin_amdgcn_exp2f(lg[kk] - mx); lg[kk] = pv; sum += pv; }
        sum = wave_sum(sum);
        asm volatile("s_waitcnt lgkmcnt(0)" ::: "memory");
        float o = 0.f;
        for (int seg = 0; seg <= nsel; ++seg) {
            const int blk = (seg < nsel) ? (seg == 0 ? sel0 : (seg == 1 ? sel1 : sel2)) : qb; const int cnt = (seg < nsel) ? 256 : nown;
            const bf16* vp = Vb + (size_t)blk * 256 * 64 + lane; const LAS float* pp = lg + seg * 256;
#pragma unroll 4
            for (int k = 0; k < cnt; ++k) o += pp[k] * bf2f(vp[(size_t)k * 64]);
        }
        O[((size_t)(b * SEQ + t)) * 512 + h * 64 + lane] = (bf16)f2bf(o / sum);
        asm volatile("s_waitcnt lgkmcnt(0)" ::: "memory");
    }
}

struct Args { const float* in[24]; float* out; unsigned char* ws; int ph_lo, ph_hi; };
constexpr int N_PHASES = 12;
__global__ void __launch_bounds__(NTHREADS, 2) mk_fwd(Args args) {
    extern __shared__ __attribute__((aligned(16))) unsigned char lds[];
    Frame F;
    F.lds = (LAS unsigned char*)lds;
    F.tid = threadIdx.x; F.lane = F.tid & 63; F.wave = __builtin_amdgcn_readfirstlane(F.tid >> 6);
    F.G = gridDim.x; { const int bx = blockIdx.x; F.vcu = (F.G % 8 == 0) ? (bx % 8) * (F.G / 8) + bx / 8 : bx; }
#pragma unroll
    for (int i = 0; i < 24; ++i) F.in[i] = args.in[i];
    F.out = args.out; F.ws = args.ws;
    unsigned char* ws = args.ws;
    const int lo = args.ph_lo, hi = args.ph_hi;
    for (int u = F.tid; u < (LDS_BYTES - LDSCTL_OFF) / 4; u += NTHREADS) ((LAS unsigned*)(F.lds + LDSCTL_OFF))[u] = 0u;
    __syncthreads();
    XcdBarrier bar = xcd_barrier_post((unsigned*)(ws + WS_CTL) + CW_BAR, (volatile LAS unsigned*)(F.lds + MISC_OFF) + 8);
#define GRID_BAR(k) do { if (IN(k) && IN((k) + 1)) xcd_barrier(bar); } while (0)
#define IN(k) (lo <= (k) && (k) < hi)
    if (IN(0)) { p0a_weights_mod(F); }
    GRID_BAR(0);
    if (IN(1)) { p0b_hn(F); }
    GRID_BAR(1);
    if (IN(2)) {
        pg8::Gemm g{(const bf16*)(ws + WS_HN), (const bf16*)(ws + WS_WIN), MT, INW, DM}; pg8::StaticOrder S; S.init(MT, INW, F.G, (int)blockIdx.x);
        pg8::EpiProj E{(bf16*)(ws + WS_UG), (bf16*)(ws + WS_QH), (bf16*)(ws + WS_G), (size_t)(WS_KH - WS_QH) / 2, QSCALE};
        static_assert(WS_VH - WS_KH == WS_KH - WS_QH, "q|k|v equally spaced");
        pg8::gemm_phase<pg8::EpiProj, pg8::StaticOrder, true, true>(F.lds + RING_OFF, g, S, E);
    }
    GRID_BAR(2);
    if (IN(3)) { kmean_phase(F); ssm_simple_phase(F); }
    GRID_BAR(3);
    if (IN(4)) { attn_simple_phase(F); }
    GRID_BAR(4);
    if (IN(5)) {
        pg8::Gemm g{(const bf16*)(ws + WS_Z), (const bf16*)(ws + WS_WGLU), MT, 2048, 512}; pg8::StaticOrder S; S.init(MT, 2048, F.G, (int)blockIdx.x);
        pg8::EpiGlu E{(const bf16*)(ws + WS_G), (bf16*)(ws + WS_T1)};
        pg8::gemm_phase<pg8::EpiGlu, pg8::StaticOrder, true, true>(F.lds + RING_OFF, g, S, E);
    }
    GRID_BAR(5);
    if (IN(6)) {
        pg8::Gemm g{(const bf16*)(ws + WS_O), (const bf16*)(ws + WS_WAO), MT, 1024, 512}; pg8::StaticOrder S; S.init(MT, 1024, F.G, (int)blockIdx.x);
        pg8::EpiMerge E{(const bf16*)(ws + WS_G), (const bf16*)(ws + WS_T1), (bf16*)(ws + WS_MG)};
        pg8::gemm_phase<pg8::EpiMerge, pg8::StaticOrder, true, true>(F.lds + RING_OFF, g, S, E);
    }
    GRID_BAR(6);
    if (IN(7)) {
        pg8::Gemm g{(const bf16*)(ws + WS_MG), (const bf16*)(ws + WS_WOUT), MT, 1024, 1024}; pg8::StaticOrder S; S.init(MT, 1024, F.G, (int)blockIdx.x);
        pg8::EpiF32 E{(float*)(ws + WS_Y1), 1024};
        pg8::gemm_phase<pg8::EpiF32, pg8::StaticOrder, true, true>(F.lds + RING_OFF, g, S, E);
    }
    GRID_BAR(7);
    if (IN(8)) { norm_pass1(F); }
    GRID_BAR(8);
    if (IN(9)) {
        pg8::Gemm g{(const bf16*)(ws + WS_HN), (const bf16*)(ws + WS_WGU), MT, 2 * FF, 1024}; pg8::StaticOrder S; S.init(MT, 2 * FF, F.G, (int)blockIdx.x);
        pg8::EpiSwiGlu E{(bf16*)(ws + WS_H)};
        pg8::gemm_phase<pg8::EpiSwiGlu, pg8::StaticOrder, true, true>(F.lds + RING_OFF, g, S, E);
    }
    GRID_BAR(9);
    if (IN(10)) {
        pg8::Gemm g{(const bf16*)(ws + WS_H), (const bf16*)(ws + WS_WDN), MT, 1024, FF}; pg8::StaticOrder S; S.init(MT, 1024, F.G, (int)blockIdx.x);
        pg8::EpiF32 E{(float*)(ws + WS_Y2), 1024};
        pg8::gemm_phase<pg8::EpiF32, pg8::StaticOrder, true, true>(F.lds + RING_OFF, g, S, E);
    }
    GRID_BAR(10);
    if (IN(11)) { norm_pass2(F); }
#undef IN
#undef GRID_BAR
}

extern "C" void kernel_launch(void* const* d_in, const int* in_sizes, int n_in, void* d_out, int out_size, void* d_ws, size_t ws_size, hipStream_t stream) {
    static int grid = 0;
    if (grid == 0) {
        if (n_in != 24 || in_sizes[0] != MT * DM || out_size != MT * DM || ws_size < WS_END) { fprintf(stderr, "kernel_launch: unexpected shapes (n_in %d, in0 %d, out %d, ws %zu); nothing launched\n", n_in, n_in > 0 ? in_sizes[0] : -1, out_size, ws_size); grid = -1; return; }
        int dev = 0, cus = 0;
        if (hipGetDevice(&dev) != hipSuccess || hipDeviceGetAttribute(&cus, hipDeviceAttributeMultiprocessorCount, dev) != hipSuccess) { grid = -1; return; }
        if (hipFuncSetAttribute((const void*)mk_fwd, hipFuncAttributeMaxDynamicSharedMemorySize, LDS_BYTES) != hipSuccess) { fprintf(stderr, "kernel_launch: hipFuncSetAttribute failed\n"); grid = -1; return; }
        (void)hipGetLastError();
        grid = cus;
    }
    if (grid < 0) return;
    (void)hipMemsetAsync((char*)d_ws + WS_CTL, 0, CTL_ZERO_BYTES, stream);
    Args a{};
    for (int i = 0; i < 24; ++i) a.in[i] = (const float*)d_in[i];
    a.out = (float*)d_out; a.ws = (unsigned char*)d_ws;
    a.ph_lo = 0; a.ph_hi = N_PHASES;
    hipLaunchKernelGGL(mk_fwd, dim3(grid), dim3(NTHREADS), LDS_BYTES, stream, a);
}
```

```cpp
#include <hip/hip_runtime.h>
#include <cstdio>
#include <cstdint>

constexpr int NB = 4, SEQ = 8192, DM = 1024, MT = NB * SEQ;
constexpr int SSM_W = 512, NGRP = 32, GCH = 16, NST = 64;
constexpr int NH = 8, HD = 64, AW = 512, MBLK = 256, NBLK = SEQ / MBLK, TOPK = 3;
constexpr int INW = 4096, FF = 2816, NMOD = 6;
constexpr float NORM_EPS = 1e-6f;
constexpr float LOG2E = 1.4426950408889634f;
constexpr float QSCALE = 0.125f * LOG2E;
namespace pg8 {
#define PG8_LAS __attribute__((address_space(3)))
typedef unsigned short bf16_t;
typedef short bf16x8 __attribute__((ext_vector_type(8)));
typedef float f32x4 __attribute__((ext_vector_type(4)));
typedef unsigned u32x4 __attribute__((ext_vector_type(4)));
constexpr int BM = 256, BK = 64, HALF = 128, HTB = HALF * BK * 2  , STAGE_BYTES = 8 * HTB, NXCD = 8, WGM = 8;

__host__ __device__ __forceinline__ int lds_byte(int r, int c) { const int st = (r >> 4) * 2 + (c >> 5), rr = r & 15, cc = c & 31, ob = rr * 64 + cc * 2; return st * 1024 + (ob ^ (((ob >> 9) & 1) << 5)); }
__host__ __device__ __forceinline__ void stage_rc(int b, int& R, int& C) { const int st = b / 1024, sb = b % 1024, swz = sb ^ (((sb >> 9) & 1) << 5); R = (st >> 1) * 16 + swz / 64; C = (st & 1) * 32 + (swz % 64) / 2; }
__host__ __device__ __forceinline__ int perm32(int rho) { const int n = rho >> 4, i = rho & 15; return 8 * (i >> 2) + 4 * n + (i & 3); }

struct Unit { int pm, pn; };
struct Gemm { const bf16_t* A; const bf16_t* Bt; int M, N, K; };

struct StaticOrder {
    int nM, nN, nwg, G, c;
    __host__ __device__ void init(int M, int N, int G_, int c_) { nM = M / BM; nN = N / BM; nwg = nM * nN; G = G_; c = c_; }
    __host__ __device__ bool next(int i, Unit& u) const {
        const long L = (long)i * G + c; if (L >= nwg) return false;
        int wgid = (int)L; { const int q = nwg / NXCD, r = nwg % NXCD, xcd = wgid % NXCD, off = wgid / NXCD; wgid = (xcd < r ? xcd * (q + 1) : r * (q + 1) + (xcd - r) * q) + off; }
        const int nig = WGM * nN, gid = wgid / nig, fm = gid * WGM, gsz = (nM - fm) < WGM ? (nM - fm) : WGM;
        u.pm = fm + ((wgid % nig) % gsz); u.pn = (wgid % nig) / gsz; return true;
    }
    __device__ __forceinline__ void a_ready(const Unit&) const {}
    __device__ __forceinline__ void done(const Unit&) const {}
};

typedef float f32x2c_t __attribute__((ext_vector_type(2))); typedef __bf16 bf16x2c_t __attribute__((ext_vector_type(2)));
__device__ __forceinline__ unsigned cvt_pk_bf16(float lo, float hi) { f32x2c_t v = {lo, hi}; bf16x2c_t b = __builtin_convertvector(v, bf16x2c_t); return __builtin_bit_cast(unsigned, b); }
typedef float f32x2 __attribute__((ext_vector_type(2)));
__device__ __forceinline__ f32x2 gelu_pk(f32x2 v) {
    const f32x2 av = __builtin_elementwise_abs(v), d = av * 0.2316418882f + 1.0f;
    f32x2 t; t.x = __builtin_amdgcn_rcpf(d.x); t.y = __builtin_amdgcn_rcpf(d.y);
    f32x2 q = t * 0.5307027145f + (-0.7265760135f); q = q * t + 0.7107068705f; q = q * t + (-0.142248368f); q = q * t + 0.127414796f; q = q * t;
    const f32x2 s = (v * v) * (-0.72134752044f);
    f32x2 e; e.x = __builtin_amdgcn_exp2f(s.x); e.y = __builtin_amdgcn_exp2f(s.y);
    const f32x2 m = v * (q * e), r = v - m;
    f32x2 o; o.x = v.x < 0.f ? m.x : r.x; o.y = v.y < 0.f ? m.y : r.y; return o;
}

template <int ACT  > struct EpiBf16 {
    static constexpr bool PERM = true, AFTER_DRAIN = false; static_assert(ACT == 0 || ACT == 1, "EpiBf16: ACT is 0 (none) or 1 (gelu_pk)");
    bf16_t* O; int ldc; const float* bias; int split_cols; size_t split_stride; float scale0;
    __device__ __forceinline__ void operator()(const f32x4 (&acc)[2][2][4][2], const Unit& u, int wr, int wc, int fr, int fq) const {
        const int row0 = u.pm * BM + wr * 64 + fr; int colt = u.pn * BM; bf16_t* base = O;
        float sc = 1.f; if (split_cols) { const int t = colt / split_cols; base += (size_t)t * split_stride; colt -= t * split_cols; if (t == 0) sc = scale0; }
        const int col0 = colt + wc * 32 + 8 * fq, bcol0 = u.pn * BM + wc * 32 + 8 * fq;
        f32x4 bv[2][2];
#pragma unroll
        for (int bj = 0; bj < 2; ++bj)
#pragma unroll
            for (int n = 0; n < 2; ++n) bv[bj][n] = bias ? *(const f32x4*)(bias + bcol0 + bj * HALF + 4 * n) : (f32x4){0.f, 0.f, 0.f, 0.f};
#pragma unroll
        for (int ai = 0; ai < 2; ++ai)
#pragma unroll
            for (int m = 0; m < 4; ++m) { bf16_t* rowp = base + (size_t)(row0 + ai * HALF + m * 16) * ldc + col0;
#pragma unroll
                for (int bj = 0; bj < 2; ++bj) { f32x4 v0 = acc[ai][bj][m][0] + bv[bj][0], v1 = acc[ai][bj][m][1] + bv[bj][1];
                    if (ACT == 1) { f32x2 a = gelu_pk((f32x2){v0[0], v0[1]}), b = gelu_pk((f32x2){v0[2], v0[3]}), c = gelu_pk((f32x2){v1[0], v1[1]}), d = gelu_pk((f32x2){v1[2], v1[3]});
                        v0 = (f32x4){a.x, a.y, b.x, b.y}; v1 = (f32x4){c.x, c.y, d.x, d.y}; }
                    v0 = v0 * sc; v1 = v1 * sc; u32x4 w; w.x = cvt_pk_bf16(v0[0], v0[1]); w.y = cvt_pk_bf16(v0[2], v0[3]); w.z = cvt_pk_bf16(v1[0], v1[1]); w.w = cvt_pk_bf16(v1[2], v1[3]);
                    *(u32x4*)(rowp + bj * HALF) = w; } }
    }
};


__device__ __forceinline__ float sigm(float x) { return __builtin_amdgcn_rcpf(1.0f + __builtin_amdgcn_exp2f(-1.4426950408889634f * x)); }
__device__ __forceinline__ f32x4 sigm4(f32x4 v) { return (f32x4){sigm(v[0]), sigm(v[1]), sigm(v[2]), sigm(v[3])}; }
__device__ __forceinline__ u32x4 pack8(f32x4 v0, f32x4 v1) { u32x4 w; w.x = cvt_pk_bf16(v0[0], v0[1]); w.y = cvt_pk_bf16(v0[2], v0[3]); w.z = cvt_pk_bf16(v1[0], v1[1]); w.w = cvt_pk_bf16(v1[2], v1[3]); return w; }
__device__ __forceinline__ void unpack8(u32x4 w, f32x4& v0, f32x4& v1) {
    v0 = (f32x4){__uint_as_float(w.x << 16), __uint_as_float(w.x & 0xffff0000u), __uint_as_float(w.y << 16), __uint_as_float(w.y & 0xffff0000u)};
    v1 = (f32x4){__uint_as_float(w.z << 16), __uint_as_float(w.z & 0xffff0000u), __uint_as_float(w.w << 16), __uint_as_float(w.w & 0xffff0000u)};
}

struct EpiProj {
    static constexpr bool PERM = true, AFTER_DRAIN = false;
    bf16_t *UG, *QH, *G; size_t qkv_stride; float qscale;
    __device__ __forceinline__ void operator()(const f32x4 (&acc)[2][2][4][2], const Unit& u, int wr, int wc, int fr, int fq) const {
        const int pn = u.pn, row0 = u.pm * BM + wr * 64 + fr, cw = wc * 32 + 8 * fq;
        if (pn >= 8) {
#pragma unroll
            for (int ai = 0; ai < 2; ++ai)
#pragma unroll
                for (int m = 0; m < 4; ++m) { const int r = row0 + ai * HALF + m * 16; bf16_t* rowp = G + (size_t)r * 2048 + (pn * 256 - 2048) + cw;
#pragma unroll
                    for (int bj = 0; bj < 2; ++bj) *(u32x4*)(rowp + bj * HALF) = pack8(sigm4(acc[ai][bj][m][0]), sigm4(acc[ai][bj][m][1])); }
        } else if (pn >= 2) {
            const int t = (pn - 2) >> 1; bf16_t* base = QH + (size_t)t * qkv_stride; const float sc = t == 0 ? qscale : 1.0f;
#pragma unroll
            for (int ai = 0; ai < 2; ++ai)
#pragma unroll
                for (int m = 0; m < 4; ++m) { const int r = row0 + ai * HALF + m * 16, b = r >> 13, s = r & 8191;
#pragma unroll
                    for (int bj = 0; bj < 2; ++bj) { const int cc = (pn & 1) * 256 + bj * 128 + cw, h = cc >> 6, d = cc & 63;
                        bf16_t* dst = base + ((size_t)((b * 8 + h) * 8192 + s)) * 64 + d;
                        *(u32x4*)dst = pack8(acc[ai][bj][m][0] * sc, acc[ai][bj][m][1] * sc); } }
        } else {
#pragma unroll
            for (int ai = 0; ai < 2; ++ai)
#pragma unroll
                for (int m = 0; m < 4; ++m) { const int r = row0 + ai * HALF + m * 16, b = r >> 13, s = r & 8191;
#pragma unroll
                    for (int bj = 0; bj < 2; ++bj) { const int cc = pn * 256 + bj * 128 + cw, g = cc >> 4;
                        bf16_t* dst = UG + ((size_t)((b * 32 + g) * 8192 + s)) * 16 + (cc & 8);
                        *(u32x4*)dst = pack8(acc[ai][bj][m][0], acc[ai][bj][m][1]); } }
        }
    }
};
struct EpiGlu {
    static constexpr bool PERM = true, AFTER_DRAIN = false;
    const bf16_t* G; bf16_t* T1;
    __device__ __forceinline__ void operator()(const f32x4 (&acc)[2][2][4][2], const Unit& u, int wr, int wc, int fr, int fq) const {
        const int row0 = u.pm * BM + wr * 64 + fr, col = u.pn * 128 + wc * 32 + 8 * fq;
#pragma unroll
        for (int ai = 0; ai < 2; ++ai)
#pragma unroll
            for (int m = 0; m < 4; ++m) { const int r = row0 + ai * HALF + m * 16;
                f32x4 g0, g1; unpack8(*(const u32x4*)(G + (size_t)r * 2048 + col), g0, g1);
                const f32x4 t0 = acc[ai][0][m][0] * sigm4(acc[ai][1][m][0]) * g0, t1 = acc[ai][0][m][1] * sigm4(acc[ai][1][m][1]) * g1;
                *(u32x4*)(T1 + (size_t)r * 1024 + col) = pack8(t0, t1); }
    }
};
struct EpiMerge {
    static constexpr bool PERM = true, AFTER_DRAIN = false;
    const bf16_t* G; const bf16_t* T1; bf16_t* MG;
    __device__ __forceinline__ void operator()(const f32x4 (&acc)[2][2][4][2], const Unit& u, int wr, int wc, int fr, int fq) const {
        const int row0 = u.pm * BM + wr * 64 + fr, col0 = u.pn * BM + wc * 32 + 8 * fq;
#pragma unroll
        for (int ai = 0; ai < 2; ++ai)
#pragma unroll
            for (int m = 0; m < 4; ++m) { const int r = row0 + ai * HALF + m * 16;
#pragma unroll
                for (int bj = 0; bj < 2; ++bj) { const int col = col0 + bj * HALF;
                    f32x4 g0, g1, t0, t1; unpack8(*(const u32x4*)(G + (size_t)r * 2048 + 1024 + col), g0, g1); unpack8(*(const u32x4*)(T1 + (size_t)r * 1024 + col), t0, t1);
                    *(u32x4*)(MG + (size_t)r * 1024 + col) = pack8(t0 + g0 * acc[ai][bj][m][0], t1 + g1 * acc[ai][bj][m][1]); } }
    }
};
struct EpiSwiGlu {
    static constexpr bool PERM = true, AFTER_DRAIN = false;
    bf16_t* H;
    __device__ __forceinline__ void operator()(const f32x4 (&acc)[2][2][4][2], const Unit& u, int wr, int wc, int fr, int fq) const {
        const int row0 = u.pm * BM + wr * 64 + fr, col = u.pn * 128 + wc * 32 + 8 * fq;
#pragma unroll
        for (int ai = 0; ai < 2; ++ai)
#pragma unroll
            for (int m = 0; m < 4; ++m) { const int r = row0 + ai * HALF + m * 16;
                const f32x4 a0 = acc[ai][0][m][0], a1 = acc[ai][0][m][1];
                *(u32x4*)(H + (size_t)r * 2816 + col) = pack8(a0 * sigm4(a0) * acc[ai][1][m][0], a1 * sigm4(a1) * acc[ai][1][m][1]); }
    }
};
struct EpiF32 {
    static constexpr bool PERM = false, AFTER_DRAIN = false;
    float* C; int ldc;
    __device__ __forceinline__ void operator()(const f32x4 (&acc)[2][2][4][2], const Unit& u, int wr, int wc, int fr, int fq) const {
        const int row0 = u.pm * BM + wr * 64 + fr, col0 = u.pn * BM + wc * 32 + 4 * fq;
#pragma unroll
        for (int ai = 0; ai < 2; ++ai)
#pragma unroll
            for (int m = 0; m < 4; ++m) { float* rowp = C + (size_t)(row0 + ai * HALF + m * 16) * ldc + col0;
#pragma unroll
                for (int bj = 0; bj < 2; ++bj)
#pragma unroll
                    for (int n = 0; n < 2; ++n) *(f32x4*)(rowp + bj * HALF + n * 16) = acc[ai][bj][m][n]; }
    }
};
template <class Epi, class Sched, bool ALIGN_EPI = false, bool SP2 = false>
__device__ __forceinline__ void gemm_phase(PG8_LAS unsigned char* lds, const Gemm g, const Sched& S, const Epi& E) {
    const int tid = threadIdx.x, wid = __builtin_amdgcn_readfirstlane(tid >> 6), lane = tid & 63, wr = wid >> 2, wc = wid & 3, fr = lane & 15, fq = lane >> 4;
    const int K = g.K, nt = K / BK;
    unsigned voffA[2], voffB[2];
#pragma unroll
    for (int i = 0; i < 2; ++i) { int R, C; stage_rc(tid * 16 + i * 8192, R, C); const int Rb = Epi::PERM ? ((R & ~31) + perm32(R & 31)) : R;
        voffA[i] = (unsigned)(R * K + C) * 2u; voffB[i] = (unsigned)(Rb * K + C) * 2u; }
    const size_t kstep = (size_t)(BK * 2);
    const size_t hstep = (size_t)HALF * K * 2;
    const size_t tstep = 2 * hstep;
    const unsigned ldsw = (unsigned)wid * 1024u;
    const int aoff = lds_byte(wr * 64 + fr, fq * 8), boff = lds_byte(wc * 32 + fr, fq * 8);
#define PG8_SA(b, h) (((b) * 2 + (h)) * HTB)
#define PG8_SB(b, h) ((4 + (b) * 2 + (h)) * HTB)
#define PG8_STAGE(bufoff, gbase, voff) do { _Pragma("unroll") for (int _i = 0; _i < 2; ++_i) \
        __builtin_amdgcn_global_load_lds((const unsigned*)((const char*)(gbase) + (voff)[_i]), (PG8_LAS unsigned*)(lds + (bufoff) + ldsw + _i * 8192), 16, 0, 0); } while (0)
#define PG8_LDA(dst, b, h) do { _Pragma("unroll") for (int m = 0; m < 4; ++m) _Pragma("unroll") for (int k = 0; k < 2; ++k) dst[m][k] = *(const PG8_LAS bf16x8*)(lds + PG8_SA(b, h) + aoff + m * 2048 + k * 1024); } while (0)
#define PG8_LDB(dst, b, h) do { _Pragma("unroll") for (int n = 0; n < 2; ++n) _Pragma("unroll") for (int k = 0; k < 2; ++k) dst[n][k] = *(const PG8_LAS bf16x8*)(lds + PG8_SB(b, h) + boff + n * 2048 + k * 1024); } while (0)
#define PG8_MMA(ai, bj, At, Bt) do { __builtin_amdgcn_s_setprio(1); _Pragma("unroll") for (int m = 0; m < 4; ++m) _Pragma("unroll") for (int n = 0; n < 2; ++n) _Pragma("unroll") for (int k = 0; k < 2; ++k) \
        acc[ai][bj][m][n] = __builtin_amdgcn_mfma_f32_16x16x32_bf16(Bt[n][k], At[m][k], acc[ai][bj][m][n], 0, 0, 0); __builtin_amdgcn_s_setprio(0); } while (0)
#define PG8_WAIT_V(n) asm volatile("s_waitcnt vmcnt(" #n ")" ::: "memory")
#define PG8_WAIT_L(n) asm volatile("s_waitcnt lgkmcnt(" #n ")" ::: "memory")
#define PG8_BAR __builtin_amdgcn_s_barrier()
#define PG8_SCHED __builtin_amdgcn_sched_barrier(0)
    Unit cur, nxt; int ui = 0;
    if (!S.next(0, cur)) return;
    f32x4 acc[2][2][4][2];
#pragma unroll
    for (int a = 0; a < 2; ++a)
#pragma unroll
        for (int b = 0; b < 2; ++b)
#pragma unroll
            for (int m = 0; m < 4; ++m)
#pragma unroll
                for (int n = 0; n < 2; ++n) acc[a][b][m][n] = (f32x4){0.f, 0.f, 0.f, 0.f};
    bf16x8 At[4][2], B0[2][2], B1[2][2];
    const char* cA = (const char*)g.A + (size_t)cur.pm * tstep; const char* cB = (const char*)g.Bt + (size_t)cur.pn * tstep;
    S.a_ready(cur);
    if constexpr (SP2) {
        PG8_STAGE(PG8_SB(0, 0), cB, voffB); PG8_STAGE(PG8_SB(0, 1), cB + hstep, voffB); PG8_STAGE(PG8_SA(0, 0), cA, voffA); PG8_STAGE(PG8_SA(0, 1), cA + hstep, voffA);
        if (wr == 1) PG8_BAR;
        PG8_WAIT_V(2); PG8_BAR;
        PG8_STAGE(PG8_SB(1, 0), cB + kstep, voffB); PG8_STAGE(PG8_SA(1, 0), cA + kstep, voffA); PG8_STAGE(PG8_SB(1, 1), cB + hstep + kstep, voffB);
        PG8_WAIT_V(6); PG8_BAR;
    } else {
        PG8_STAGE(PG8_SB(0, 0), cB, voffB); PG8_STAGE(PG8_SA(0, 0), cA, voffA); PG8_STAGE(PG8_SB(0, 1), cB + hstep, voffB); PG8_STAGE(PG8_SA(0, 1), cA + hstep, voffA);
        if (wr == 1) PG8_BAR;
        PG8_WAIT_V(4); PG8_BAR;
        PG8_STAGE(PG8_SB(1, 0), cB + kstep, voffB); PG8_STAGE(PG8_SA(1, 0), cA + kstep, voffA); PG8_STAGE(PG8_SB(1, 1), cB + hstep + kstep, voffB);
        PG8_WAIT_V(6); PG8_BAR;
    }
    for (;;) {
        const bool has_next = S.next(ui + 1, nxt);
        const char* nA = has_next ? (const char*)g.A + (size_t)nxt.pm * tstep : cA; const char* nB = has_next ? (const char*)g.Bt + (size_t)nxt.pn * tstep : cB;
        for (int t = 0; t < nt; t += 2) {
            const bool last = (t == nt - 2);
            const char* a1 = cA + (size_t)(t + 1) * kstep;
            const char* a2 = last ? nA : cA + (size_t)(t + 2) * kstep; const char* b2 = last ? nB : cB + (size_t)(t + 2) * kstep;
            const char* a3 = a2 + kstep; const char* b3 = b2 + kstep;
            if (last && has_next) S.a_ready(nxt);
            if constexpr (SP2) {
            PG8_LDB(B0, 0, 0); PG8_LDB(B1, 0, 1); PG8_SCHED; PG8_LDA(At, 0, 0); PG8_STAGE(PG8_SA(1, 1), a1 + hstep, voffA);
            PG8_WAIT_V(8); PG8_WAIT_L(0); PG8_BAR; PG8_MMA(0, 0, At, B0); PG8_MMA(0, 1, At, B1); PG8_BAR; PG8_SCHED;
            PG8_LDA(At, 0, 1); PG8_STAGE(PG8_SB(0, 0), b2, voffB); PG8_STAGE(PG8_SB(0, 1), b2 + hstep, voffB); PG8_STAGE(PG8_SA(0, 0), a2, voffA);
            PG8_WAIT_V(8); PG8_WAIT_L(0); PG8_BAR; PG8_MMA(1, 0, At, B0); PG8_MMA(1, 1, At, B1); PG8_BAR; PG8_SCHED;
            PG8_LDB(B0, 1, 0); PG8_LDB(B1, 1, 1); PG8_SCHED; PG8_LDA(At, 1, 0); PG8_STAGE(PG8_SA(0, 1), a2 + hstep, voffA);
            PG8_WAIT_V(8); PG8_WAIT_L(0); PG8_BAR; PG8_MMA(0, 0, At, B0); PG8_MMA(0, 1, At, B1); PG8_BAR; PG8_SCHED;
            PG8_LDA(At, 1, 1); PG8_STAGE(PG8_SB(1, 0), b3, voffB); PG8_STAGE(PG8_SB(1, 1), b3 + hstep, voffB); PG8_STAGE(PG8_SA(1, 0), a3, voffA);
            PG8_WAIT_V(8); PG8_WAIT_L(0); PG8_BAR; PG8_MMA(1, 0, At, B0); PG8_MMA(1, 1, At, B1); PG8_BAR; PG8_SCHED;
            } else {
            PG8_LDB(B0, 0, 0); PG8_SCHED; PG8_LDA(At, 0, 0); PG8_STAGE(PG8_SA(1, 1), a1 + hstep, voffA);
            PG8_WAIT_L(8); PG8_BAR; PG8_WAIT_L(0); PG8_MMA(0, 0, At, B0); PG8_BAR; PG8_SCHED;
            PG8_LDB(B1, 0, 1); PG8_STAGE(PG8_SB(0, 0), b2, voffB);
            PG8_BAR; PG8_WAIT_L(0); PG8_MMA(0, 1, At, B1); PG8_BAR;
            PG8_LDA(At, 0, 1); PG8_STAGE(PG8_SA(0, 0), a2, voffA);
            PG8_BAR; PG8_WAIT_L(0); PG8_MMA(1, 0, At, B0); PG8_BAR; PG8_SCHED;
            PG8_STAGE(PG8_SB(0, 1), b2 + hstep, voffB);
            PG8_WAIT_V(6); PG8_BAR; PG8_MMA(1, 1, At, B1); PG8_BAR;
            PG8_LDB(B0, 1, 0); PG8_SCHED; PG8_LDA(At, 1, 0); PG8_STAGE(PG8_SA(0, 1), a2 + hstep, voffA);
            PG8_WAIT_L(8); PG8_BAR; PG8_WAIT_L(0); PG8_MMA(0, 0, At, B0); PG8_BAR; PG8_SCHED;
            PG8_LDB(B1, 1, 1); PG8_STAGE(PG8_SB(1, 0), b3, voffB);
            PG8_BAR; PG8_WAIT_L(0); PG8_MMA(0, 1, At, B1); PG8_BAR;
            PG8_LDA(At, 1, 1); PG8_STAGE(PG8_SA(1, 0), a3, voffA);
            PG8_BAR; PG8_WAIT_L(0); PG8_MMA(1, 0, At, B0); PG8_BAR; PG8_SCHED;
            PG8_STAGE(PG8_SB(1, 1), b3 + hstep, voffB);
            PG8_WAIT_V(6); PG8_BAR; PG8_MMA(1, 1, At, B1); PG8_BAR;
            }
        }
        if constexpr (ALIGN_EPI) { if (wr == 0) PG8_BAR; }
        if constexpr (!Epi::AFTER_DRAIN) { E(acc, cur, wr, wc, fr, fq); S.done(cur); }
        if (!has_next) break;
#pragma unroll
        for (int a = 0; a < 2; ++a)
#pragma unroll
            for (int b = 0; b < 2; ++b)
#pragma unroll
                for (int m = 0; m < 4; ++m)
#pragma unroll
                    for (int n = 0; n < 2; ++n) acc[a][b][m][n] = (f32x4){0.f, 0.f, 0.f, 0.f};
        cur = nxt; cA = nA; cB = nB; ++ui;
        if constexpr (ALIGN_EPI) { if (wr == 1) PG8_BAR; }
    }
    PG8_WAIT_V(0);
    if constexpr (!ALIGN_EPI) { if (wr == 0) PG8_BAR; }
    PG8_BAR;
    if constexpr (Epi::AFTER_DRAIN) { E.fused(acc, cur, wr, wc, fr, fq, lds, wid, lane); S.done(cur); }
#undef PG8_SA
#undef PG8_SB
#undef PG8_STAGE
#undef PG8_LDA
#undef PG8_LDB
#undef PG8_MMA
#undef PG8_WAIT_V
#undef PG8_WAIT_L
#undef PG8_BAR
#undef PG8_SCHED
}
}
#define GAS __attribute__((address_space(1)))
#define LAS __attribute__((address_space(3)))
typedef unsigned short bf16;
typedef unsigned v4u __attribute__((ext_vector_type(4)));
typedef float f32x4 __attribute__((ext_vector_type(4)));
typedef short bf16x8 __attribute__((ext_vector_type(8)));
typedef GAS unsigned gu32;
typedef GAS unsigned long long gu64;
#define RLX_AGENT __ATOMIC_RELAXED, __HIP_MEMORY_SCOPE_AGENT
#define LDS_WAIT() asm volatile("s_waitcnt lgkmcnt(0)" ::: "memory")
#define VM_WAIT() asm volatile("s_waitcnt vmcnt(0)" ::: "memory")
__device__ __forceinline__ unsigned long long rt() { return __builtin_amdgcn_s_memrealtime(); }
__device__ __forceinline__ unsigned f2bf(float f) { unsigned u = __builtin_bit_cast(unsigned, f); return (u + 0x7fffu + ((u >> 16) & 1u)) >> 16; }
__device__ __forceinline__ unsigned pk2(float lo, float hi) { return f2bf(lo) | (f2bf(hi) << 16); }

#define XB_TMO      128
#define XB_XCNT(j)  (256  + 64 * (j))
#define XB_XSUB(j)  (1280 + 64 * (j))
#define XB_XGEN(j)  (2304 + 64 * (j))
#define XB_TOP      3328
#define XB_TOPGEN   3392
#define XCD_BAR_WORDS 3456
#define XB_SPIN_CAP (1u << 18)

__device__ __forceinline__ unsigned xb_ld(unsigned* p)              { return __hip_atomic_load(p, __ATOMIC_RELAXED, __HIP_MEMORY_SCOPE_AGENT); }
__device__ __forceinline__ unsigned xb_add(unsigned* p, unsigned v) { return __hip_atomic_fetch_add(p, v, __ATOMIC_RELAXED, __HIP_MEMORY_SCOPE_AGENT); }
__device__ __forceinline__ unsigned xb_xcc_id() { return (unsigned)__builtin_amdgcn_s_getreg((3 << 11) | 20) & 0xFu; }
#define XB_SPIN(cond, bar) do { unsigned _sp = 0; while (cond) { __builtin_amdgcn_s_sleep(1); \
    if ((++_sp & 255u) == 0u) { if (xb_ld(&(bar)[XB_TMO])) break; if (_sp > XB_SPIN_CAP) { atomicAdd(&(bar)[XB_TMO], 1u); break; } } } } while (0)

struct XcdBarrier {
    unsigned* bar; unsigned x;
    volatile LAS unsigned* st;
};

__device__ __forceinline__ XcdBarrier xcd_barrier_post(unsigned* bar, volatile LAS unsigned* st) {
    XcdBarrier b; b.bar = bar; b.x = xb_xcc_id(); b.st = st;
    if (threadIdx.x == 0) (void)xb_add(&bar[XB_XCNT(b.x)], 1u);
    return b;
}
__device__ __forceinline__ void xcd_barrier_complete(unsigned* bar, unsigned x, unsigned& nloc, unsigned& nx) {
    const unsigned G = gridDim.x * gridDim.y * gridDim.z;
    unsigned sum, cnt, mine, sp = 0u;
    for (;;) {
        sum = 0u; cnt = 0u; mine = 0u;
#pragma unroll
        for (unsigned j = 0; j < 16; ++j) { const unsigned c = xb_ld(&bar[XB_XCNT(j)]); sum += c; cnt += (c > 0u) ? 1u : 0u; mine = (j == x) ? c : mine; }
        if (sum == G) break;
        __builtin_amdgcn_s_sleep(1);
        if ((++sp & 255u) == 0u) { if (xb_ld(&bar[XB_TMO])) break; if (sp > XB_SPIN_CAP) { atomicAdd(&bar[XB_TMO], 1u); break; } }
    }
    nloc = mine > 0u ? mine : 1u; nx = cnt > 0u ? cnt : 1u;
}

__device__ __forceinline__ void xcd_barrier(const XcdBarrier& b) {
    asm volatile("s_waitcnt vmcnt(0)" ::: "memory");
    __syncthreads();
    if (threadIdx.x == 0) {
        unsigned* bar = b.bar;
        __builtin_amdgcn_s_waitcnt(0);
        unsigned nloc = b.st[0], nx = b.st[1];
        if (nloc == 0u) { xcd_barrier_complete(bar, b.x, nloc, nx); b.st[0] = nloc; b.st[1] = nx; }
        const unsigned old = xb_add(&bar[XB_XSUB(b.x)], 1u);
        const unsigned gen = old / nloc;
        if (old + 1u == (gen + 1u) * nloc) {
            __builtin_amdgcn_fence(__ATOMIC_RELEASE, "agent");
            asm volatile("s_waitcnt vmcnt(0)" ::: "memory");
            const unsigned og = xb_add(&bar[XB_TOP], 1u);
            const unsigned tg = og / nx;
            if (og + 1u == (tg + 1u) * nx) xb_add(&bar[XB_TOPGEN], 1u);
            else XB_SPIN(xb_ld(&bar[XB_TOPGEN]) == tg, bar);
            __builtin_amdgcn_fence(__ATOMIC_ACQUIRE, "agent");
            xb_add(&bar[XB_XGEN(b.x)], 1u);
            asm volatile("s_waitcnt vmcnt(0)" ::: "memory");
        } else {
            XB_SPIN(xb_ld(&bar[XB_XGEN(b.x)]) == gen, bar);
            __builtin_amdgcn_fence(__ATOMIC_ACQUIRE, "agent");
            asm volatile("s_waitcnt vmcnt(0)" ::: "memory");
        }
    }
    __syncthreads();
}

constexpr size_t MiB = 1u << 20;
constexpr size_t WS_CTL = 0, CTL_ZERO_BYTES = 1 * MiB;
constexpr int CW_BAR = 4096;
constexpr size_t WS_MOD = 1 * MiB;
constexpr size_t WS_KMEAN = 1 * MiB + 256 * 1024;
constexpr size_t WS_SSMT = 2 * MiB;
constexpr size_t WS_WIN = 28 * MiB, WS_WGLU = 36 * MiB, WS_WAO = 38 * MiB, WS_WOUT = 39 * MiB, WS_WGU = 41 * MiB, WS_WDN = 52 * MiB;
constexpr size_t WS_HN = 58 * MiB;
constexpr size_t WS_UG = 122 * MiB, WS_QH = 154 * MiB, WS_KH = 186 * MiB, WS_VH = 218 * MiB, WS_VT = 250 * MiB;
constexpr size_t WS_G = 282 * MiB;
constexpr size_t WS_Z = 410 * MiB, WS_O = 442 * MiB;
constexpr size_t WS_T1 = 122 * MiB;
constexpr size_t WS_MG = 186 * MiB;
constexpr size_t WS_H = 122 * MiB;
constexpr size_t WS_Y1 = 282 * MiB;
constexpr size_t WS_Y2 = 298 * MiB;
constexpr size_t WS_END = 474 * MiB;

constexpr int RING_OFF = 0, RING_BYTES = 131072;
constexpr int LDS_BYTES = 163840;
constexpr int LDSCTL_OFF = LDS_BYTES - 512, MISC_OFF = LDSCTL_OFF + 320;
constexpr int NWAVES = 8, NTHREADS = 512;

__device__ __forceinline__ float bf2f(bf16 b) { return __uint_as_float(((unsigned)b) << 16); }
__device__ __forceinline__ float wave_sum(float v) {
#pragma unroll
    for (int o = 1; o < 64; o <<= 1) v += __shfl_xor(v, o);
    return v;
}
__device__ __forceinline__ float wave_max(float v) {
#pragma unroll
    for (int o = 1; o < 64; o <<= 1) v = fmaxf(v, __shfl_xor(v, o));
    return v;
}


namespace moba {
typedef short bf16x8 __attribute__((ext_vector_type(8)));
typedef float f32x16 __attribute__((ext_vector_type(16)));
typedef unsigned u32x4 __attribute__((ext_vector_type(4)));
typedef short v4i16_t __attribute__((ext_vector_type(4)));
constexpr int A_Q = 0, A_PO = 32768, A_PM = 131072, A_PL = 135168, A_SEL = 139264, A_CNT = 140288, A_ITEM = 140544, A_LIST = 140672, A_WSF = 157056, A_END = 159104;
__device__ __forceinline__ int opq(int v) { asm volatile("" : "+v"(v)); return v; }
__device__ __forceinline__ int crow(int r, int hi) { return (r & 3) + 8 * (r >> 2) + 4 * hi; }
__device__ __forceinline__ float rowmax32(const f32x16& p0, const f32x16& p1) {
    float a = fmaxf(fmaxf(p0[0], p0[1]), p1[0]), b = fmaxf(fmaxf(p0[2], p0[3]), p1[1]); a = fmaxf(fmaxf(a, p1[2]), p1[3]);
#pragma unroll
    for (int r = 4; r < 16; r += 4) { a = fmaxf(fmaxf(a, p0[r]), p0[r + 1]); b = fmaxf(fmaxf(b, p0[r + 2]), p0[r + 3]); a = fmaxf(fmaxf(a, p1[r]), p1[r + 1]); b = fmaxf(fmaxf(b, p1[r + 2]), p1[r + 3]); }
    const float m = fmaxf(a, b);
    auto rr = __builtin_amdgcn_permlane32_swap(__float_as_uint(m), __float_as_uint(m), false, false);
    return fmaxf(__uint_as_float(rr[0]), __uint_as_float(rr[1]));
}
__device__ __forceinline__ float halves_sum(float v) { auto rr = __builtin_amdgcn_permlane32_swap(__float_as_uint(v), __float_as_uint(v), false, false); return __uint_as_float(rr[0]) + __uint_as_float(rr[1]); }
__device__ __forceinline__ unsigned pk(float lo, float hi) { return pg8::cvt_pk_bf16(lo, hi); }

template <bool MASK>
__device__ __forceinline__ void tile_pass(const bf16* __restrict__ Kb, const bf16* __restrict__ Vt, int kblk, int nt, const LAS unsigned char* qrow, int qsw, int qi, float tq, float sl2_,
                                          int r32, int hi, LAS float* wsf, f32x16 (&o)[2], float& mhat_out, float& l_out) {
    o[0] = f32x16{}; o[1] = f32x16{};
    float mhat = 0.f, l = 0.f;
    const GAS bf16* kp = (const GAS bf16*)Kb + (size_t)(kblk * 256 + r32) * 64 + 8 * hi;
    const GAS bf16* vp = (const GAS bf16*)Vt + (size_t)r32 * 8192 + kblk * 256 + 8 * hi;
    bf16x8 kf[8];
#pragma unroll
    for (int d0 = 0; d0 < 4; ++d0) { kf[2 * d0] = *(const GAS bf16x8*)(kp + 16 * d0); kf[2 * d0 + 1] = *(const GAS bf16x8*)(kp + 32 * 64 + 16 * d0); }
#pragma unroll 1
    for (int kt = 0; kt < nt; ++kt) {
        bf16x8 vf[8];
#pragma unroll
        for (int ks = 0; ks < 4; ++ks) { vf[ks] = *(const GAS bf16x8*)(vp + 64 * kt + 16 * ks); vf[4 + ks] = *(const GAS bf16x8*)(vp + (size_t)32 * 8192 + 64 * kt + 16 * ks); }
        float sl2 = sl2_; asm volatile("" : "+v"(sl2) :: "memory");
        bf16x8 qr[4];
#pragma unroll
        for (int d0 = 0; d0 < 4; ++d0) qr[d0] = *(const LAS bf16x8*)(qrow + (((2 * d0) ^ qsw) << 4));
        const float cb = sl2 * ((float)(kblk * 256 + 64 * kt + 4 * hi) - tq) - mhat;
        f32x16 p0, p1;
#pragma unroll
        for (int r = 0; r < 16; ++r) { p0[r] = cb + sl2 * (float)((r & 3) + 8 * (r >> 2)); p1[r] = p0[r] + 32.0f * sl2; }
#pragma unroll
        for (int d0 = 0; d0 < 4; ++d0) { p0 = __builtin_amdgcn_mfma_f32_32x32x16_bf16(kf[2 * d0], qr[d0], p0, 0, 0, 0); p1 = __builtin_amdgcn_mfma_f32_32x32x16_bf16(kf[2 * d0 + 1], qr[d0], p1, 0, 0, 0); }
        if (kt + 1 < nt) {
#pragma unroll
            for (int d0 = 0; d0 < 4; ++d0) { kf[2 * d0] = *(const GAS bf16x8*)(kp + (size_t)(64 * (kt + 1)) * 64 + 16 * d0); kf[2 * d0 + 1] = *(const GAS bf16x8*)(kp + (size_t)(64 * (kt + 1) + 32) * 64 + 16 * d0); }
        }
        if (MASK) { const int kb = 64 * kt + 4 * hi;
#pragma unroll
            for (int r = 0; r < 16; ++r) { const int kk = kb + (r & 3) + 8 * (r >> 2); if (kk > qi) p0[r] = -INFINITY; if (kk + 32 > qi) p1[r] = -INFINITY; } }
        const float rm = rowmax32(p0, p1);
        if (kt == 0) {
            mhat = rm;
#pragma unroll
            for (int r = 0; r < 16; ++r) { p0[r] -= rm; p1[r] -= rm; }
        } else if (__any(rm > 0.f)) {
            const float dl = fmaxf(rm, 0.f); mhat += dl;
#pragma unroll
            for (int r = 0; r < 16; ++r) { p0[r] -= dl; p1[r] -= dl; }
            const float f = __builtin_amdgcn_exp2f(-dl); l *= f;
            if (hi == 0) wsf[r32] = f;
            asm volatile("s_waitcnt lgkmcnt(0)" ::: "memory");
#pragma unroll
            for (int r = 0; r < 16; ++r) { const float fr_ = wsf[crow(r, hi)]; o[0][r] *= fr_; o[1][r] *= fr_; }
            asm volatile("s_waitcnt lgkmcnt(0)" ::: "memory");
        }
        float sacc = 0.f;
#pragma unroll
        for (int r = 0; r < 16; ++r) { p0[r] = __builtin_amdgcn_exp2f(p0[r]); p1[r] = __builtin_amdgcn_exp2f(p1[r]); sacc += p0[r] + p1[r]; }
        l += sacc;
        u32x4 pw0 = {pk(p0[0], p0[1]), pk(p0[2], p0[3]), pk(p0[4], p0[5]), pk(p0[6], p0[7])}, pw1 = {pk(p0[8], p0[9]), pk(p0[10], p0[11]), pk(p0[12], p0[13]), pk(p0[14], p0[15])};
        u32x4 pw2 = {pk(p1[0], p1[1]), pk(p1[2], p1[3]), pk(p1[4], p1[5]), pk(p1[6], p1[7])}, pw3 = {pk(p1[8], p1[9]), pk(p1[10], p1[11]), pk(p1[12], p1[13]), pk(p1[14], p1[15])};
        o[0] = __builtin_amdgcn_mfma_f32_32x32x16_bf16(__builtin_bit_cast(bf16x8, pw0), vf[0], o[0], 0, 0, 0); o[1] = __builtin_amdgcn_mfma_f32_32x32x16_bf16(__builtin_bit_cast(bf16x8, pw0), vf[4], o[1], 0, 0, 0);
        o[0] = __builtin_amdgcn_mfma_f32_32x32x16_bf16(__builtin_bit_cast(bf16x8, pw1), vf[1], o[0], 0, 0, 0); o[1] = __builtin_amdgcn_mfma_f32_32x32x16_bf16(__builtin_bit_cast(bf16x8, pw1), vf[5], o[1], 0, 0, 0);
        o[0] = __builtin_amdgcn_mfma_f32_32x32x16_bf16(__builtin_bit_cast(bf16x8, pw2), vf[2], o[0], 0, 0, 0); o[1] = __builtin_amdgcn_mfma_f32_32x32x16_bf16(__builtin_bit_cast(bf16x8, pw2), vf[6], o[1], 0, 0, 0);
        o[0] = __builtin_amdgcn_mfma_f32_32x32x16_bf16(__builtin_bit_cast(bf16x8, pw3), vf[3], o[0], 0, 0, 0); o[1] = __builtin_amdgcn_mfma_f32_32x32x16_bf16(__builtin_bit_cast(bf16x8, pw3), vf[7], o[1], 0, 0, 0);
    }
    mhat_out = mhat; l_out = halves_sum(l);
}

__device__ __forceinline__ void attn_phase(LAS unsigned char* lds, int tid_, int vcu, int G, const bf16* QH, const bf16* KH, const bf16* VT, const float* KM, bf16* O) {
    const int w = __builtin_amdgcn_readfirstlane(tid_ >> 6);
    LAS unsigned char* Qs = lds + A_Q; LAS bf16* Po = (LAS bf16*)(lds + A_PO); LAS float* KMs = (LAS float*)(lds + A_PO);
    LAS float* Pm = (LAS float*)(lds + A_PM); LAS float* Pl = (LAS float*)(lds + A_PL); LAS unsigned char* sel = lds + A_SEL;
    LAS int* cnt = (LAS int*)(lds + A_CNT); LAS int* nitems_p = cnt + 32; LAS int* counter_p = cnt + 33;
    LAS unsigned short* items = (LAS unsigned short*)(lds + A_ITEM); LAS unsigned short* lists = (LAS unsigned short*)(lds + A_LIST);
    LAS float* wsf = (LAS float*)(lds + A_WSF) + w * 64;
    for (int ui = vcu; ui < NB * NH * NBLK; ui += G) {
        const int bh = ui >> 5, qb = (ui + 11 * (ui >> 8)) & 31, h = bh & 7, b = bh >> 3;
        const float sl2 = __builtin_amdgcn_exp2f(-(float)(h + 1)) * LOG2E;
        const bf16* Qb = QH + ((size_t)bh * SEQ + qb * 256) * 64; const bf16* Kb = KH + (size_t)bh * SEQ * 64; const bf16* Vt = VT + (size_t)bh * 64 * SEQ;
        __syncthreads();
        { const int tid = opq(tid_);
#pragma unroll
        for (int i = 0; i < 4; ++i) { const int idx = tid + 512 * i, row = idx >> 3, c = idx & 7;
            *(LAS u32x4*)(Qs + row * 128 + ((c ^ (row & 7)) << 4)) = *(const GAS u32x4*)(Qb + row * 64 + c * 8); }
        for (int i = tid; i < qb * 64; i += NTHREADS) KMs[i] = KM[(size_t)bh * 32 * 64 + i];
        if (tid < 32) cnt[tid] = 0;
        if (tid == 32) { *counter_p = 0; *nitems_p = 0; }
        }
        __syncthreads();
        const int nsel = qb < 3 ? qb : 3;
        { const int tid = opq(tid_);
        if (tid < 256 && qb > 0) {
            float qv[64];
#pragma unroll
            for (int c = 0; c < 8; ++c) { const u32x4 wv = *(const LAS u32x4*)(Qs + tid * 128 + ((c ^ (tid & 7)) << 4));
                qv[8 * c + 0] = __uint_as_float(wv.x << 16); qv[8 * c + 1] = __uint_as_float(wv.x & 0xffff0000u); qv[8 * c + 2] = __uint_as_float(wv.y << 16); qv[8 * c + 3] = __uint_as_float(wv.y & 0xffff0000u);
                qv[8 * c + 4] = __uint_as_float(wv.z << 16); qv[8 * c + 5] = __uint_as_float(wv.z & 0xffff0000u); qv[8 * c + 6] = __uint_as_float(wv.w << 16); qv[8 * c + 7] = __uint_as_float(wv.w & 0xffff0000u); }
            float v0 = -INFINITY, v1 = -INFINITY, v2 = -INFINITY; int i0 = 255, i1 = 255, i2 = 255;
            for (int j = 0; j < qb; ++j) {
                float s0 = 0.f, s1 = 0.f;
#pragma unroll
                for (int d = 0; d < 64; d += 8) { const f32x4 ka = *(const LAS f32x4*)(KMs + j * 64 + d), kb2 = *(const LAS f32x4*)(KMs + j * 64 + d + 4);
                    s0 += qv[d] * ka.x + qv[d + 1] * ka.y + qv[d + 2] * ka.z + qv[d + 3] * ka.w; s1 += qv[d + 4] * kb2.x + qv[d + 5] * kb2.y + qv[d + 6] * kb2.z + qv[d + 7] * kb2.w; }
                const float s = s0 + s1;
                if (s > v0) { v2 = v1; i2 = i1; v1 = v0; i1 = i0; v0 = s; i0 = j; }
                else if (s > v1) { v2 = v1; i2 = i1; v1 = s; i1 = j; }
                else if (s > v2) { v2 = s; i2 = j; }
            }
            *(LAS unsigned*)(sel + tid * 4) = (unsigned)i0 | ((unsigned)i1 << 8) | ((unsigned)i2 << 16) | 0xff000000u;
        }
        }
        __syncthreads();
        { const int lane = opq(tid_) & 63;
        for (int j = w; j < qb; j += 8) {
            int base = 0;
#pragma unroll
            for (int c = 0; c < 4; ++c) { const int q = 64 * c + lane; const unsigned s3 = *(const LAS unsigned*)(sel + q * 4);
                const int a0 = s3 & 255, a1 = (s3 >> 8) & 255, a2 = (s3 >> 16) & 255; const bool hit = (a0 == j) | (a1 == j) | (a2 == j); const int slot = (a0 == j) ? 0 : ((a1 == j) ? 1 : 2);
                const unsigned long long mask = __ballot(hit); const int pre = __builtin_amdgcn_mbcnt_hi((unsigned)(mask >> 32), __builtin_amdgcn_mbcnt_lo((unsigned)mask, 0u));
                if (hit) lists[j * 256 + base + pre] = (unsigned short)(q | (slot << 8));
                base += __builtin_popcountll(mask); }
            if (lane == 0) cnt[j] = base;
        }
        }
        __syncthreads();
        if (tid_ == 0) { int n = 0; for (int j = 0; j < qb; ++j) { const int c = cnt[j]; for (int t = 0; t * 32 < c; ++t) items[n++] = (unsigned short)(j | (t << 8)); } *nitems_p = n; }
        __syncthreads();
        const int nitems = *nitems_p;
        for (;;) {
            const int lane = opq(tid_) & 63, r32 = lane & 31, hi = lane >> 5;
            int it = 0; if (lane == 0) it = __hip_atomic_fetch_add(counter_p, 1, __ATOMIC_RELAXED, __HIP_MEMORY_SCOPE_WORKGROUP);
            it = __builtin_amdgcn_readfirstlane(it);
            if (it >= nitems) break;
            const int item = items[it], j = item & 255, tl = item >> 8; int n = cnt[j] - 32 * tl; n = n > 32 ? 32 : n; const int e0 = j * 256 + 32 * tl;
            const int ent = lists[e0 + (r32 < n ? r32 : 0)], qi = ent & 255, slot = ent >> 8;
            f32x16 o[2]; float mh, ls;
            tile_pass<false>(Kb, Vt, j, 4, Qs + qi * 128, hi ^ (qi & 7), qi, (float)(qb * 256 + qi), sl2, r32, hi, wsf, o, mh, ls);
#pragma unroll
            for (int r = 0; r < 16; ++r) { const int ql = crow(r, hi);
                if (ql < n) { const int e2 = lists[e0 + ql]; LAS bf16* dst = Po + ((e2 & 255) * 3 + (e2 >> 8)) * 64 + r32;
                    dst[0] = (bf16)(pk(o[0][r], 0.f) & 0xffffu); dst[32] = (bf16)(pk(o[1][r], 0.f) & 0xffffu); }
                if ((r & 3) == 3) asm volatile("" ::: "memory"); }
            if (hi == 0 && r32 < n) { Pm[qi * 4 + slot] = mh; Pl[qi * 4 + slot] = ls; }
        }
        f32x16 o[2]; float mown, lown;
        { const int lane = opq(tid_) & 63, r32 = lane & 31, hi = lane >> 5; const int qi = 32 * w + r32;
            tile_pass<true>(Kb, Vt, qb, (w >> 1) + 1, Qs + qi * 128, hi ^ (qi & 7), qi, (float)(qb * 256 + qi), sl2, r32, hi, wsf, o, mown, lown); }
        __syncthreads();
        const int lane = opq(tid_) & 63, r32 = lane & 31, hi = lane >> 5;
        if (hi == 0) { wsf[r32] = mown; wsf[32 + r32] = lown; }
        asm volatile("s_waitcnt lgkmcnt(0)" ::: "memory");
        bf16* Ob = O + ((size_t)b * SEQ + qb * 256 + 32 * w) * 512 + h * 64 + r32;
#pragma unroll
        for (int r = 0; r < 16; ++r) { const int ql = crow(r, hi), q = 32 * w + ql;
            const float mo = wsf[ql], lo = wsf[32 + ql];
            float m0 = -INFINITY, m1 = -INFINITY, m2 = -INFINITY, l0 = 0.f, l1 = 0.f, l2 = 0.f, a0 = 0.f, a1 = 0.f, a2 = 0.f, c0 = 0.f, c1 = 0.f, c2 = 0.f;
            if (nsel > 0) { m0 = Pm[q * 4 + 0]; l0 = Pl[q * 4 + 0]; a0 = bf2f(Po[(q * 3 + 0) * 64 + r32]); c0 = bf2f(Po[(q * 3 + 0) * 64 + 32 + r32]); }
            if (nsel > 1) { m1 = Pm[q * 4 + 1]; l1 = Pl[q * 4 + 1]; a1 = bf2f(Po[(q * 3 + 1) * 64 + r32]); c1 = bf2f(Po[(q * 3 + 1) * 64 + 32 + r32]); }
            if (nsel > 2) { m2 = Pm[q * 4 + 2]; l2 = Pl[q * 4 + 2]; a2 = bf2f(Po[(q * 3 + 2) * 64 + r32]); c2 = bf2f(Po[(q * 3 + 2) * 64 + 32 + r32]); }
            const float mm = fmaxf(fmaxf(mo, m0), fmaxf(m1, m2));
            const float wo = __builtin_amdgcn_exp2f(mo - mm), w0 = __builtin_amdgcn_exp2f(m0 - mm), w1 = __builtin_amdgcn_exp2f(m1 - mm), w2 = __builtin_amdgcn_exp2f(m2 - mm);
            const float ltot = wo * lo + w0 * l0 + w1 * l1 + w2 * l2, inv = 1.0f / ltot;
            const float x0 = (wo * o[0][r] + w0 * a0 + w1 * a1 + w2 * a2) * inv, x1 = (wo * o[1][r] + w0 * c0 + w1 * c1 + w2 * c2) * inv;
            Ob[(size_t)ql * 512] = (bf16)f2bf(x0); Ob[(size_t)ql * 512 + 32] = (bf16)f2bf(x1);
            if (r & 1) asm volatile("" ::: "memory"); }
    }
}

__device__ __forceinline__ void kmean_vt_phase(LAS unsigned char* lds, int tid, int vcu, int G, const bf16* KH, const bf16* VH, float* KM, bf16* VT) {
    const int lane = tid & 63, w = __builtin_amdgcn_readfirstlane(tid >> 6), gw = vcu * 8 + w, NGW = G * 8;
    for (int u = gw; u < NB * NH * NBLK; u += NGW) {
        const bf16* kp = KH + (size_t)u * MBLK * 64 + lane; float s = 0.f;
#pragma unroll 8
        for (int k = 0; k < MBLK; ++k) s += bf2f(kp[k * 64]);
        KM[u * 64 + lane] = s * (1.0f / 256.0f);
    }
    LAS unsigned char* tile = lds + w * 8192;
    for (int u = gw; u < NB * NH * (SEQ / 64); u += NGW) {
        const int bh = u >> 7, kg = u & 127;
        const bf16* vp = VH + ((size_t)bh * SEQ + kg * 64) * 64;
#pragma unroll
        for (int i = 0; i < 8; ++i) { const int idx = lane + 64 * i, row = idx >> 3, c = idx & 7; *(LAS u32x4*)(tile + row * 128 + c * 16) = *(const GAS u32x4*)(vp + row * 64 + c * 8); }
        asm volatile("s_waitcnt lgkmcnt(0)" ::: "memory");
        const int gg = lane >> 4, q4 = (lane >> 2) & 3, p4 = lane & 3;
        bf16* vt = VT + ((size_t)bh * 64 + lane) * SEQ + kg * 64;
#pragma unroll
        for (int g16 = 0; g16 < 4; ++g16) {
            v4i16_t t[4];
#pragma unroll
            for (int k4 = 0; k4 < 4; ++k4) t[k4] = __builtin_amdgcn_ds_read_tr16_b64_v4i16((LAS v4i16_t*)(tile + (g16 * 16 + k4 * 4 + q4) * 128 + (gg * 16 + p4 * 4) * 2));
            typedef short s16x8 __attribute__((ext_vector_type(8)));
            const s16x8 lo = {t[0][0], t[0][1], t[0][2], t[0][3], t[2][0], t[2][1], t[2][2], t[2][3]}, hi8 = {t[1][0], t[1][1], t[1][2], t[1][3], t[3][0], t[3][1], t[3][2], t[3][3]};
            *(GAS s16x8*)(vt + g16 * 16) = lo; *(GAS s16x8*)(vt + g16 * 16 + 8) = hi8;
        }
        asm volatile("s_waitcnt lgkmcnt(0)" ::: "memory");
    }
}
}
struct Frame {
    LAS unsigned char* lds;
    int tid, lane, wave, vcu, G;
    const float* in[24]; float* out; unsigned char* ws;
};
enum { I_X = 0, I_C, I_WADA, I_BADA, I_GPRE_MIX, I_GPOST_MIX, I_WIN, I_ARE, I_AIM, I_LOGDT, I_BRE, I_BIM, I_CRE, I_CIM, I_SD, I_WGLUA, I_WGLUB, I_WAO, I_WOUT, I_GPRE_FFN, I_GPOST_FFN, I_WGATE, I_WUP, I_WDOWN };

__device__ __forceinline__ void transpose_item(const float* W, int K, int N, bf16* WT, int k0, int n0, int drow0, LAS float* scr, int lane) {
#pragma unroll 8
    for (int i = 0; i < 32; ++i) { const int kk = 2 * i + (lane >> 5); scr[kk * 33 + (lane & 31)] = W[(size_t)(k0 + kk) * N + n0 + (lane & 31)]; }
    LDS_WAIT(); asm volatile("" ::: "memory");
    const int c = lane & 7;
#pragma unroll
    for (int j = 0; j < 4; ++j) { const int n = (lane >> 3) + 8 * j; const LAS float* s = scr + (8 * c) * 33 + n;
        v4u o; o.x = pk2(s[0 * 33], s[1 * 33]); o.y = pk2(s[2 * 33], s[3 * 33]); o.z = pk2(s[4 * 33], s[5 * 33]); o.w = pk2(s[6 * 33], s[7 * 33]);
        *(GAS v4u*)(WT + (size_t)(drow0 + n) * K + k0 + 8 * c) = o; }
    LDS_WAIT(); asm volatile("" ::: "memory");
}
__device__ __forceinline__ int ilv_row(int n0, int which) { return 256 * (n0 >> 7) + 128 * which + (n0 & 127); }

__device__ __forceinline__ void p0a_weights_mod(Frame& F) {
    LAS float* scr = (LAS float*)(F.lds + RING_OFF + F.wave * 16384);
    const int gw = F.vcu * NWAVES + F.wave, NGW = F.G * NWAVES;
    bf16* WIN = (bf16*)(F.ws + WS_WIN); bf16* WGLU = (bf16*)(F.ws + WS_WGLU); bf16* WAO = (bf16*)(F.ws + WS_WAO); bf16* WOUT = (bf16*)(F.ws + WS_WOUT); bf16* WGU = (bf16*)(F.ws + WS_WGU); bf16* WDN = (bf16*)(F.ws + WS_WDN);
    constexpr int I_IN = 16 * 128, I_GA = 8 * 32, I_AO = 8 * 32, I_OUT = 16 * 32, I_GT = 16 * 88, I_DN = 44 * 32;
    constexpr int NITEMS = I_IN + 2 * I_GA + I_AO + I_OUT + 2 * I_GT + I_DN;
    for (int it = gw; it < NITEMS; it += NGW) {
        int r = it;
        if (r < I_IN) { const int kb = r / 128, nb = r % 128; transpose_item(F.in[I_WIN], 1024, 4096, WIN, 64 * kb, 32 * nb, 32 * nb, scr, F.lane); continue; } r -= I_IN;
        if (r < I_GA) { const int kb = r / 32, nb = r % 32; transpose_item(F.in[I_WGLUA], 512, 1024, WGLU, 64 * kb, 32 * nb, ilv_row(32 * nb, 0), scr, F.lane); continue; } r -= I_GA;
        if (r < I_GA) { const int kb = r / 32, nb = r % 32; transpose_item(F.in[I_WGLUB], 512, 1024, WGLU, 64 * kb, 32 * nb, ilv_row(32 * nb, 1), scr, F.lane); continue; } r -= I_GA;
        if (r < I_AO) { const int kb = r / 32, nb = r % 32; transpose_item(F.in[I_WAO], 512, 1024, WAO, 64 * kb, 32 * nb, 32 * nb, scr, F.lane); continue; } r -= I_AO;
        if (r < I_OUT) { const int kb = r / 32, nb = r % 32; transpose_item(F.in[I_WOUT], 1024, 1024, WOUT, 64 * kb, 32 * nb, 32 * nb, scr, F.lane); continue; } r -= I_OUT;
        if (r < I_GT) { const int kb = r / 88, nb = r % 88; transpose_item(F.in[I_WGATE], 1024, 2816, WGU, 64 * kb, 32 * nb, ilv_row(32 * nb, 0), scr, F.lane); continue; } r -= I_GT;
        if (r < I_GT) { const int kb = r / 88, nb = r % 88; transpose_item(F.in[I_WUP], 1024, 2816, WGU, 64 * kb, 32 * nb, ilv_row(32 * nb, 1), scr, F.lane); continue; } r -= I_GT;
        { const int kb = r / 32, nb = r % 32; transpose_item(F.in[I_WDOWN], 2816, 1024, WDN, 64 * kb, 32 * nb, 32 * nb, scr, F.lane); }
    }
    __syncthreads();
    if (F.vcu < 96) {
        LAS float* cact = (LAS float*)(F.lds + RING_OFF);
        LAS float* red = cact + 4096;
        for (int i = F.tid; i < 4096; i += NTHREADS) { const float cv = F.in[I_C][i]; cact[i] = cv / (1.0f + __expf(-cv)); }
        __syncthreads();
        const float* wada = F.in[I_WADA]; float* mod = (float*)(F.ws + WS_MOD);
        for (int it = F.vcu; it < 96; it += F.G) {
            const int col = F.tid & 63, ks = F.tid >> 6, n = it * 64 + col;
            float a0 = 0.f, a1 = 0.f, a2 = 0.f, a3 = 0.f;
#pragma unroll 4
            for (int k = ks * 128; k < ks * 128 + 128; ++k) { const float w = wada[(size_t)k * 6144 + n]; a0 += cact[k] * w; a1 += cact[1024 + k] * w; a2 += cact[2048 + k] * w; a3 += cact[3072 + k] * w; }
            red[(ks * 4 + 0) * 64 + col] = a0; red[(ks * 4 + 1) * 64 + col] = a1; red[(ks * 4 + 2) * 64 + col] = a2; red[(ks * 4 + 3) * 64 + col] = a3;
            __syncthreads();
            if (F.tid < 256) { const int b = F.tid >> 6, c = F.tid & 63; float s = F.in[I_BADA][it * 64 + c];
#pragma unroll
                for (int q = 0; q < 8; ++q) s += red[(q * 4 + b) * 64 + c];
                mod[b * 6144 + it * 64 + c] = s; }
            __syncthreads();
        }
    }
}

__device__ __forceinline__ void adaln_row(int lane, const float* xrow, const float* gw, const float* sc, const float* sh, bf16* orow) {
    const GAS f32x4* xr = (const GAS f32x4*)xrow + lane;
    f32x4 v[4]; float s = 0.f;
#pragma unroll
    for (int j = 0; j < 4; ++j) { v[j] = xr[64 * j]; s += (v[j].x * v[j].x + v[j].y * v[j].y) + (v[j].z * v[j].z + v[j].w * v[j].w); }
    const float rstd = 1.0f / sqrtf(wave_sum(s) * (1.0f / 1024.0f) + NORM_EPS);
    GAS unsigned long long* o8 = (GAS unsigned long long*)orow + lane;
#pragma unroll
    for (int j = 0; j < 4; ++j) { const f32x4 g4 = ((const GAS f32x4*)gw + lane)[64 * j], sc4 = ((const GAS f32x4*)sc + lane)[64 * j], sh4 = ((const GAS f32x4*)sh + lane)[64 * j];
        const f32x4 o = v[j] * rstd * g4 * (sc4 + 1.0f) + sh4;
        o8[64 * j] = (unsigned long long)pk2(o.x, o.y) | ((unsigned long long)pk2(o.z, o.w) << 32); }
}
__device__ __forceinline__ void p0b_hn(Frame& F) {
    const int gw = F.vcu * NWAVES + F.wave, NGW = F.G * NWAVES;
    const float* mod = (const float*)(F.ws + WS_MOD); bf16* HN = (bf16*)(F.ws + WS_HN);
    for (int m = gw; m < MT; m += NGW) { const int b = m >> 13;
        adaln_row(F.lane, F.in[I_X] + (size_t)m * 1024, F.in[I_GPRE_MIX], mod + b * 6144 + 1024, mod + b * 6144, HN + (size_t)m * 1024); }
}
__device__ __forceinline__ void norm_pass1(Frame& F) {
    const int gw = F.vcu * NWAVES + F.wave, NGW = F.G * NWAVES, lane = F.lane;
    const float* mod = (const float*)(F.ws + WS_MOD); bf16* HN2 = (bf16*)(F.ws + WS_HN); const float* Y = (const float*)(F.ws + WS_Y1);
    for (int m = gw; m < MT; m += NGW) { const int b = m >> 13;
        const GAS f32x4* yr = (const GAS f32x4*)(Y + (size_t)m * 1024) + lane; const GAS f32x4* xr = (const GAS f32x4*)(F.in[I_X] + (size_t)m * 1024) + lane;
        f32x4 y[4], x1[4]; float s = 0.f;
#pragma unroll
        for (int j = 0; j < 4; ++j) { y[j] = yr[64 * j]; s += (y[j].x * y[j].x + y[j].y * y[j].y) + (y[j].z * y[j].z + y[j].w * y[j].w); }
        const float rstd = 1.0f / sqrtf(wave_sum(s) * (1.0f / 1024.0f) + NORM_EPS); float s2 = 0.f;
#pragma unroll
        for (int j = 0; j < 4; ++j) { const f32x4 g4 = ((const GAS f32x4*)F.in[I_GPOST_MIX] + lane)[64 * j], gt4 = ((const GAS f32x4*)(mod + b * 6144 + 2048) + lane)[64 * j];
            x1[j] = xr[64 * j] + gt4 * (y[j] * rstd * g4); ((GAS f32x4*)(F.out + (size_t)m * 1024) + lane)[64 * j] = x1[j];
            s2 += (x1[j].x * x1[j].x + x1[j].y * x1[j].y) + (x1[j].z * x1[j].z + x1[j].w * x1[j].w); }
        const float rstd2 = 1.0f / sqrtf(wave_sum(s2) * (1.0f / 1024.0f) + NORM_EPS);
        GAS unsigned long long* o8 = (GAS unsigned long long*)(HN2 + (size_t)m * 1024) + lane;
#pragma unroll
        for (int j = 0; j < 4; ++j) { const f32x4 g4 = ((const GAS f32x4*)F.in[I_GPRE_FFN] + lane)[64 * j], sc4 = ((const GAS f32x4*)(mod + b * 6144 + 4096) + lane)[64 * j], sh4 = ((const GAS f32x4*)(mod + b * 6144 + 3072) + lane)[64 * j];
            const f32x4 o = x1[j] * rstd2 * g4 * (sc4 + 1.0f) + sh4;
            o8[64 * j] = (unsigned long long)pk2(o.x, o.y) | ((unsigned long long)pk2(o.z, o.w) << 32); }
    }
}
__device__ __forceinline__ void norm_pass2(Frame& F) {
    const int gw = F.vcu * NWAVES + F.wave, NGW = F.G * NWAVES, lane = F.lane;
    const float* mod = (const float*)(F.ws + WS_MOD); const float* Y = (const float*)(F.ws + WS_Y2);
    for (int m = gw; m < MT; m += NGW) { const int b = m >> 13;
        const GAS f32x4* yr = (const GAS f32x4*)(Y + (size_t)m * 1024) + lane; GAS f32x4* xr = (GAS f32x4*)(F.out + (size_t)m * 1024) + lane;
        f32x4 y[4]; float s = 0.f;
#pragma unroll
        for (int j = 0; j < 4; ++j) { y[j] = yr[64 * j]; s += (y[j].x * y[j].x + y[j].y * y[j].y) + (y[j].z * y[j].z + y[j].w * y[j].w); }
        const float rstd = 1.0f / sqrtf(wave_sum(s) * (1.0f / 1024.0f) + NORM_EPS);
#pragma unroll
        for (int j = 0; j < 4; ++j) { const f32x4 g4 = ((const GAS f32x4*)F.in[I_GPOST_FFN] + lane)[64 * j], gt4 = ((const GAS f32x4*)(mod + b * 6144 + 5120) + lane)[64 * j];
            xr[64 * j] = xr[64 * j] + gt4 * (y[j] * rstd * g4); }
    }
}

__device__ __forceinline__ void kmean_phase(Frame& F) {
    const int gw = F.vcu * NWAVES + F.wave, NGW = F.G * NWAVES;
    const bf16* KH = (const bf16*)(F.ws + WS_KH); float* KM = (float*)(F.ws + WS_KMEAN);
    for (int u = gw; u < NB * NH * NBLK; u += NGW) {
        const bf16* kp = KH + (size_t)u * MBLK * 64 + F.lane; float s = 0.f;
#pragma unroll 8
        for (int k = 0; k < MBLK; ++k) s += bf2f(kp[k * 64]);
        KM[u * 64 + F.lane] = s * (1.0f / 256.0f);
    }
}

__device__ __forceinline__ float gelu_tanh(float y) {
    const float a = 0.7978845608028654f * (y + 0.044715f * y * y * y);
    const float e = __builtin_amdgcn_exp2f(2.0f * LOG2E * a);
    const float t = 1.0f - 2.0f * __builtin_amdgcn_rcpf(e + 1.0f);
    return 0.5f * y * (1.0f + t);
}
__device__ __forceinline__ void ssm_simple_phase(Frame& F) {
    const int gw = F.vcu * NWAVES + F.wave, NGW = F.G * NWAVES, lane = F.lane;
    LAS float* Cl = (LAS float*)(F.lds + RING_OFF + F.wave * 16384);
    LAS float* xs = Cl + 16 * 132;
    LAS float* us = xs + 4 * 132;
    const bf16* UG = (const bf16*)(F.ws + WS_UG); bf16* Z = (bf16*)(F.ws + WS_Z);
    for (int unit = gw; unit < NB * NGRP; unit += NGW) {
        const int b = unit >> 5, g = unit & 31, p = lane;
        const float dt = expf(F.in[I_LOGDT][g]), are = F.in[I_ARE][g * 64 + p], aim = F.in[I_AIM][g * 64 + p];
        const float mag = expf(dt * are), abr = mag * cosf(dt * aim), abi = mag * sinf(dt * aim);
        const float den = are * are + aim * aim, nr = abr - 1.0f, cor = (nr * are + abi * aim) / den, coi = (abi * are - nr * aim) / den;
        float bbr[16], bbi[16];
#pragma unroll
        for (int c = 0; c < 16; ++c) { const float br = F.in[I_BRE][(g * 64 + p) * 16 + c], bi = F.in[I_BIM][(g * 64 + p) * 16 + c]; bbr[c] = cor * br - coi * bi; bbi[c] = cor * bi + coi * br; }
#pragma unroll
        for (int c = 0; c < 16; ++c) { Cl[c * 132 + p] = F.in[I_CRE][(g * 16 + c) * 64 + p]; Cl[c * 132 + 64 + p] = -F.in[I_CIM][(g * 16 + c) * 64 + p]; }
        const float dsk = F.in[I_SD][g * 16 + (lane & 15)];
        float xr = 0.f, xi = 0.f;
        const bf16* up = UG + (size_t)(b * 32 + g) * SEQ * 16;
        const int tt = lane >> 4, c = lane & 15;
        for (int t0 = 0; t0 < SEQ; t0 += 4) {
            const float uf = bf2f(up[(size_t)t0 * 16 + lane]);
            us[lane] = uf;
            asm volatile("s_waitcnt lgkmcnt(0)" ::: "memory");
#pragma unroll
            for (int q = 0; q < 4; ++q) {
                float bur = 0.f, bui = 0.f;
#pragma unroll
                for (int cc = 0; cc < 16; ++cc) { const float uv = us[q * 16 + cc]; bur += bbr[cc] * uv; bui += bbi[cc] * uv; }
                const float nxr = abr * xr - abi * xi + bur, nxi = abr * xi + abi * xr + bui; xr = nxr; xi = nxi;
                xs[q * 132 + p] = xr; xs[q * 132 + 64 + p] = xi;
            }
            asm volatile("s_waitcnt lgkmcnt(0)" ::: "memory");
            float y = 0.f;
#pragma unroll 8
            for (int q = 0; q < 128; q += 4) { const f32x4 cv = *(const LAS f32x4*)(Cl + c * 132 + q), xv = *(const LAS f32x4*)(xs + tt * 132 + q); y += (cv.x * xv.x + cv.y * xv.y) + (cv.z * xv.z + cv.w * xv.w); }
            y += dsk * uf;
            Z[(size_t)(b * SEQ + t0 + tt) * 512 + g * 16 + c] = (bf16)f2bf(gelu_tanh(y));
            asm volatile("s_waitcnt lgkmcnt(0)" ::: "memory");
        }
    }
}

__device__ __forceinline__ void attn_simple_phase(Frame& F) {
    const int gw = F.vcu * NWAVES + F.wave, NGW = F.G * NWAVES, lane = F.lane;
    LAS float* qs = (LAS float*)(F.lds + RING_OFF + F.wave * 8192);
    LAS float* lg = qs + 64;
    const bf16* QH = (const bf16*)(F.ws + WS_QH); const bf16* KH = (const bf16*)(F.ws + WS_KH); const bf16* VH = (const bf16*)(F.ws + WS_VH);
    const float* KM = (const float*)(F.ws + WS_KMEAN); bf16* O = (bf16*)(F.ws + WS_O);
    const float NEG = -INFINITY;
    for (int unit = gw; unit < NB * NH * SEQ; unit += NGW) {
        const int t = unit & 8191, bh = unit >> 13, h = bh & 7, b = bh >> 3, qb = t >> 8;
        const float sl2 = exp2f(-(float)(h + 1)) * LOG2E;
        qs[lane] = bf2f(QH[((size_t)bh * SEQ + t) * 64 + lane]);
        asm volatile("s_waitcnt lgkmcnt(0)" ::: "memory");
        float gv = NEG;
        if (lane < qb) { const float* km = KM + ((size_t)bh * 32 + lane) * 64; float s = 0.f;
#pragma unroll 8
            for (int d = 0; d < 64; ++d) s += qs[d] * km[d];
            gv = s; }
        const int nsel = qb < 3 ? qb : 3; int sel0 = 0, sel1 = 0, sel2 = 0;
#pragma unroll
        for (int k = 0; k < 3; ++k) if (k < nsel) {
            const float m = wave_max(gv); const unsigned long long mask = __ballot(gv == m); const int idx = __ffsll((long long)mask) - 1;
            if (k == 0) sel0 = idx; else if (k == 1) sel1 = idx; else sel2 = idx;
            if (lane == idx) gv = NEG; }
        const int nown = t - qb * 256 + 1, nkeys = nsel * 256 + nown;
        const bf16* Kb = KH + (size_t)bh * SEQ * 64; const bf16* Vb = VH + (size_t)bh * SEQ * 64;
        float mx = NEG;
        for (int i = 0; i * 64 < nkeys; ++i) {
            const int kk = i * 64 + lane; const bool valid = kk < nkeys; const int seg = kk >> 8;
            const int blk = (seg < nsel) ? (seg == 0 ? sel0 : (seg == 1 ? sel1 : sel2)) : qb;
            const int pos = valid ? blk * 256 + (kk & 255) : t;
            const GAS v4u* kr = (const GAS v4u*)(Kb + (size_t)pos * 64); float dot = 0.f;
#pragma unroll
            for (int j = 0; j < 8; ++j) { const v4u w = kr[j];
                dot += qs[8 * j + 0] * __uint_as_float(w.x << 16) + qs[8 * j + 1] * __uint_as_float(w.x & 0xffff0000u) + qs[8 * j + 2] * __uint_as_float(w.y << 16) + qs[8 * j + 3] * __uint_as_float(w.y & 0xffff0000u)
                     + qs[8 * j + 4] * __uint_as_float(w.z << 16) + qs[8 * j + 5] * __uint_as_float(w.z & 0xffff0000u) + qs[8 * j + 6] * __uint_as_float(w.w << 16) + qs[8 * j + 7] * __uint_as_float(w.w & 0xffff0000u); }
            const float l = valid ? dot - sl2 * (float)(t - pos) : NEG;
            lg[kk] = l; mx = fmaxf(mx, l);
        }
        mx = wave_max(mx);
        asm volatile("s_waitcnt lgkmcnt(0)" ::: "memory");
        float sum = 0.f;
        for (int i = 0; i * 64 < nkeys; ++i) { const int kk = i * 64 + lane; const float pv = __builtin_amdgcn_exp2f(lg[kk] - mx); lg[kk] = pv; sum += pv; }
        sum = wave_sum(sum);
        asm volatile("s_waitcnt lgkmcnt(0)" ::: "memory");
        float o = 0.f;
        for (int seg = 0; seg <= nsel; ++seg) {
            const int blk = (seg < nsel) ? (seg == 0 ? sel0 : (seg == 1 ? sel1 : sel2)) : qb; const int cnt = (seg < nsel) ? 256 : nown;
            const bf16* vp = Vb + (size_t)blk * 256 * 64 + lane; const LAS float* pp = lg + seg * 256;
#pragma unroll 4
            for (int k = 0; k < cnt; ++k) o += pp[k] * bf2f(vp[(size_t)k * 64]);
        }
        O[((size_t)(b * SEQ + t)) * 512 + h * 64 + lane] = (bf16)f2bf(o / sum);
        asm volatile("s_waitcnt lgkmcnt(0)" ::: "memory");
    }
}

struct Args { const float* in[24]; float* out; unsigned char* ws; int ph_lo, ph_hi; };
constexpr int N_PHASES = 12;
__global__ void __launch_bounds__(NTHREADS, 2) mk_fwd(Args args) {
    extern __shared__ __attribute__((aligned(16))) unsigned char lds[];
    Frame F;
    F.lds = (LAS unsigned char*)lds;
    F.tid = threadIdx.x; F.lane = F.tid & 63; F.wave = __builtin_amdgcn_readfirstlane(F.tid >> 6);
    F.G = gridDim.x; { const int bx = blockIdx.x; F.vcu = (F.G % 8 == 0) ? (bx % 8) * (F.G / 8) + bx / 8 : bx; }
#pragma unroll
    for (int i = 0; i < 24; ++i) F.in[i] = args.in[i];
    F.out = args.out; F.ws = args.ws;
    unsigned char* ws = args.ws;
    const int lo = args.ph_lo, hi = args.ph_hi;
    for (int u = F.tid; u < (LDS_BYTES - LDSCTL_OFF) / 4; u += NTHREADS) ((LAS unsigned*)(F.lds + LDSCTL_OFF))[u] = 0u;
    __syncthreads();
    XcdBarrier bar = xcd_barrier_post((unsigned*)(ws + WS_CTL) + CW_BAR, (volatile LAS unsigned*)(F.lds + MISC_OFF) + 8);
#define GRID_BAR(k) do { if (IN(k) && IN((k) + 1)) xcd_barrier(bar); } while (0)
#define IN(k) (lo <= (k) && (k) < hi)
    if (IN(0)) { p0a_weights_mod(F); }
    GRID_BAR(0);
    if (IN(1)) { p0b_hn(F); }
    GRID_BAR(1);
    if (IN(2)) {
        pg8::Gemm g{(const bf16*)(ws + WS_HN), (const bf16*)(ws + WS_WIN), MT, INW, DM}; pg8::StaticOrder S; S.init(MT, INW, F.G, (int)blockIdx.x);
        pg8::EpiProj E{(bf16*)(ws + WS_UG), (bf16*)(ws + WS_QH), (bf16*)(ws + WS_G), (size_t)(WS_KH - WS_QH) / 2, QSCALE};
        static_assert(WS_VH - WS_KH == WS_KH - WS_QH, "q|k|v equally spaced");
        pg8::gemm_phase<pg8::EpiProj, pg8::StaticOrder, true, true>(F.lds + RING_OFF, g, S, E);
    }
    GRID_BAR(2);
    if (IN(3)) { moba::kmean_vt_phase(F.lds, F.tid, F.vcu, F.G, (const bf16*)(ws + WS_KH), (const bf16*)(ws + WS_VH), (float*)(ws + WS_KMEAN), (bf16*)(ws + WS_VT)); __syncthreads(); ssm_simple_phase(F); }
    GRID_BAR(3);
    if (IN(4)) { moba::attn_phase(F.lds, F.tid, F.vcu, F.G, (const bf16*)(ws + WS_QH), (const bf16*)(ws + WS_KH), (const bf16*)(ws + WS_VT), (const float*)(ws + WS_KMEAN), (bf16*)(ws + WS_O)); }
    GRID_BAR(4);
    if (IN(5)) {
        pg8::Gemm g{(const bf16*)(ws + WS_Z), (const bf16*)(ws + WS_WGLU), MT, 2048, 512}; pg8::StaticOrder S; S.init(MT, 2048, F.G, (int)blockIdx.x);
        pg8::EpiGlu E{(const bf16*)(ws + WS_G), (bf16*)(ws + WS_T1)};
        pg8::gemm_phase<pg8::EpiGlu, pg8::StaticOrder, true, true>(F.lds + RING_OFF, g, S, E);
    }
    GRID_BAR(5);
    if (IN(6)) {
        pg8::Gemm g{(const bf16*)(ws + WS_O), (const bf16*)(ws + WS_WAO), MT, 1024, 512}; pg8::StaticOrder S; S.init(MT, 1024, F.G, (int)blockIdx.x);
        pg8::EpiMerge E{(const bf16*)(ws + WS_G), (const bf16*)(ws + WS_T1), (bf16*)(ws + WS_MG)};
        pg8::gemm_phase<pg8::EpiMerge, pg8::StaticOrder, true, true>(F.lds + RING_OFF, g, S, E);
    }
    GRID_BAR(6);
    if (IN(7)) {
        pg8::Gemm g{(const bf16*)(ws + WS_MG), (const bf16*)(ws + WS_WOUT), MT, 1024, 1024}; pg8::StaticOrder S; S.init(MT, 1024, F.G, (int)blockIdx.x);
        pg8::EpiF32 E{(float*)(ws + WS_Y1), 1024};
        pg8::gemm_phase<pg8::EpiF32, pg8::StaticOrder, true, true>(F.lds + RING_OFF, g, S, E);
    }
    GRID_BAR(7);
    if (IN(8)) { norm_pass1(F); }
    GRID_BAR(8);
    if (IN(9)) {
        pg8::Gemm g{(const bf16*)(ws + WS_HN), (const bf16*)(ws + WS_WGU), MT, 2 * FF, 1024}; pg8::StaticOrder S; S.init(MT, 2 * FF, F.G, (int)blockIdx.x);
        pg8::EpiSwiGlu E{(bf16*)(ws + WS_H)};
        pg8::gemm_phase<pg8::EpiSwiGlu, pg8::StaticOrder, true, true>(F.lds + RING_OFF, g, S, E);
    }
    GRID_BAR(9);
    if (IN(10)) {
        pg8::Gemm g{(const bf16*)(ws + WS_H), (const bf16*)(ws + WS_WDN), MT, 1024, FF}; pg8::StaticOrder S; S.init(MT, 1024, F.G, (int)blockIdx.x);
        pg8::EpiF32 E{(float*)(ws + WS_Y2), 1024};
        pg8::gemm_phase<pg8::EpiF32, pg8::StaticOrder, true, true>(F.lds + RING_OFF, g, S, E);
    }
    GRID_BAR(10);
    if (IN(11)) { norm_pass2(F); }
#undef IN
#undef GRID_BAR
}

extern "C" void kernel_launch(void* const* d_in, const int* in_sizes, int n_in, void* d_out, int out_size, void* d_ws, size_t ws_size, hipStream_t stream) {
    static int grid = 0;
    if (grid == 0) {
        if (n_in != 24 || in_sizes[0] != MT * DM || out_size != MT * DM || ws_size < WS_END) { fprintf(stderr, "kernel_launch: unexpected shapes (n_in %d, in0 %d, out %d, ws %zu); nothing launched\n", n_in, n_in > 0 ? in_sizes[0] : -1, out_size, ws_size); grid = -1; return; }
        int dev = 0, cus = 0;
        if (hipGetDevice(&dev) != hipSuccess || hipDeviceGetAttribute(&cus, hipDeviceAttributeMultiprocessorCount, dev) != hipSuccess) { grid = -1; return; }
        if (hipFuncSetAttribute((const void*)mk_fwd, hipFuncAttributeMaxDynamicSharedMemorySize, LDS_BYTES) != hipSuccess) { fprintf(stderr, "kernel_launch: hipFuncSetAttribute failed\n"); grid = -1; return; }
        (void)hipGetLastError();
        grid = cus;
    }
    if (grid < 0) return;
    (void)hipMemsetAsync((char*)d_ws + WS_CTL, 0, CTL_ZERO_BYTES, stream);
    Args a{};
    for (int i = 0; i < 24; ++i) a.in[i] = (const float*)d_in[i];
    a.out = (float*)d_out; a.ws = (unsigned char*)d_ws;
    a.ph_lo = 0; a.ph_hi = N_PHASES;
    hipLaunchKernelGGL(mk_fwd, dim3(grid), dim3(NTHREADS), LDS_BYTES, stream, a);
}
```

```cpp
#include <hip/hip_runtime.h>
#include <cstdio>
#include <cstdint>

constexpr int NB = 4, SEQ = 8192, DM = 1024, MT = NB * SEQ;
constexpr int SSM_W = 512, NGRP = 32, GCH = 16, NST = 64;
constexpr int NH = 8, HD = 64, AW = 512, MBLK = 256, NBLK = SEQ / MBLK, TOPK = 3;
constexpr int INW = 4096, FF = 2816, NMOD = 6;
constexpr float NORM_EPS = 1e-6f;
constexpr float LOG2E = 1.4426950408889634f;
constexpr float QSCALE = 0.125f * LOG2E;
namespace pg8 {
#define PG8_LAS __attribute__((address_space(3)))
typedef unsigned short bf16_t;
typedef short bf16x8 __attribute__((ext_vector_type(8)));
typedef float f32x4 __attribute__((ext_vector_type(4)));
typedef unsigned u32x4 __attribute__((ext_vector_type(4)));
constexpr int BM = 256, BK = 64, HALF = 128, HTB = HALF * BK * 2  , STAGE_BYTES = 8 * HTB, NXCD = 8, WGM = 8;

__host__ __device__ __forceinline__ int lds_byte(int r, int c) { const int st = (r >> 4) * 2 + (c >> 5), rr = r & 15, cc = c & 31, ob = rr * 64 + cc * 2; return st * 1024 + (ob ^ (((ob >> 9) & 1) << 5)); }
__host__ __device__ __forceinline__ void stage_rc(int b, int& R, int& C) { const int st = b / 1024, sb = b % 1024, swz = sb ^ (((sb >> 9) & 1) << 5); R = (st >> 1) * 16 + swz / 64; C = (st & 1) * 32 + (swz % 64) / 2; }
__host__ __device__ __forceinline__ int perm32(int rho) { const int n = rho >> 4, i = rho & 15; return 8 * (i >> 2) + 4 * n + (i & 3); }

struct Unit { int pm, pn; };
struct Gemm { const bf16_t* A; const bf16_t* Bt; int M, N, K; };

struct StaticOrder {
    int nM, nN, nwg, G, c;
    __host__ __device__ void init(int M, int N, int G_, int c_) { nM = M / BM; nN = N / BM; nwg = nM * nN; G = G_; c = c_; }
    __host__ __device__ bool next(int i, Unit& u) const {
        const long L = (long)i * G + c; if (L >= nwg) return false;
        int wgid = (int)L; { const int q = nwg / NXCD, r = nwg % NXCD, xcd = wgid % NXCD, off = wgid / NXCD; wgid = (xcd < r ? xcd * (q + 1) : r * (q + 1) + (xcd - r) * q) + off; }
        const int nig = WGM * nN, gid = wgid / nig, fm = gid * WGM, gsz = (nM - fm) < WGM ? (nM - fm) : WGM;
        u.pm = fm + ((wgid % nig) % gsz); u.pn = (wgid % nig) / gsz; return true;
    }
    __device__ __forceinline__ void a_ready(const Unit&) const {}
    __device__ __forceinline__ void done(const Unit&) const {}
};

typedef float f32x2c_t __attribute__((ext_vector_type(2))); typedef __bf16 bf16x2c_t __attribute__((ext_vector_type(2)));
__device__ __forceinline__ unsigned cvt_pk_bf16(float lo, float hi) { f32x2c_t v = {lo, hi}; bf16x2c_t b = __builtin_convertvector(v, bf16x2c_t); return __builtin_bit_cast(unsigned, b); }
typedef float f32x2 __attribute__((ext_vector_type(2)));
__device__ __forceinline__ f32x2 gelu_pk(f32x2 v) {
    const f32x2 av = __builtin_elementwise_abs(v), d = av * 0.2316418882f + 1.0f;
    f32x2 t; t.x = __builtin_amdgcn_rcpf(d.x); t.y = __builtin_amdgcn_rcpf(d.y);
    f32x2 q = t * 0.5307027145f + (-0.7265760135f); q = q * t + 0.7107068705f; q = q * t + (-0.142248368f); q = q * t + 0.127414796f; q = q * t;
    const f32x2 s = (v * v) * (-0.72134752044f);
    f32x2 e; e.x = __builtin_amdgcn_exp2f(s.x); e.y = __builtin_amdgcn_exp2f(s.y);
    const f32x2 m = v * (q * e), r = v - m;
    f32x2 o; o.x = v.x < 0.f ? m.x : r.x; o.y = v.y < 0.f ? m.y : r.y; return o;
}

template <int ACT  > struct EpiBf16 {
    static constexpr bool PERM = true, AFTER_DRAIN = false; static_assert(ACT == 0 || ACT == 1, "EpiBf16: ACT is 0 (none) or 1 (gelu_pk)");
    bf16_t* O; int ldc; const float* bias; int split_cols; size_t split_stride; float scale0;
    __device__ __forceinline__ void operator()(const f32x4 (&acc)[2][2][4][2], const Unit& u, int wr, int wc, int fr, int fq) const {
        const int row0 = u.pm * BM + wr * 64 + fr; int colt = u.pn * BM; bf16_t* base = O;
        float sc = 1.f; if (split_cols) { const int t = colt / split_cols; base += (size_t)t * split_stride; colt -= t * split_cols; if (t == 0) sc = scale0; }
        const int col0 = colt + wc * 32 + 8 * fq, bcol0 = u.pn * BM + wc * 32 + 8 * fq;
        f32x4 bv[2][2];
#pragma unroll
        for (int bj = 0; bj < 2; ++bj)
#pragma unroll
            for (int n = 0; n < 2; ++n) bv[bj][n] = bias ? *(const f32x4*)(bias + bcol0 + bj * HALF + 4 * n) : (f32x4){0.f, 0.f, 0.f, 0.f};
#pragma unroll
        for (int ai = 0; ai < 2; ++ai)
#pragma unroll
            for (int m = 0; m < 4; ++m) { bf16_t* rowp = base + (size_t)(row0 + ai * HALF + m * 16) * ldc + col0;
#pragma unroll
                for (int bj = 0; bj < 2; ++bj) { f32x4 v0 = acc[ai][bj][m][0] + bv[bj][0], v1 = acc[ai][bj][m][1] + bv[bj][1];
                    if (ACT == 1) { f32x2 a = gelu_pk((f32x2){v0[0], v0[1]}), b = gelu_pk((f32x2){v0[2], v0[3]}), c = gelu_pk((f32x2){v1[0], v1[1]}), d = gelu_pk((f32x2){v1[2], v1[3]});
                        v0 = (f32x4){a.x, a.y, b.x, b.y}; v1 = (f32x4){c.x, c.y, d.x, d.y}; }
                    v0 = v0 * sc; v1 = v1 * sc; u32x4 w; w.x = cvt_pk_bf16(v0[0], v0[1]); w.y = cvt_pk_bf16(v0[2], v0[3]); w.z = cvt_pk_bf16(v1[0], v1[1]); w.w = cvt_pk_bf16(v1[2], v1[3]);
                    *(u32x4*)(rowp + bj * HALF) = w; } }
    }
};


__device__ __forceinline__ float sigm(float x) { return __builtin_amdgcn_rcpf(1.0f + __builtin_amdgcn_exp2f(-1.4426950408889634f * x)); }
__device__ __forceinline__ f32x4 sigm4(f32x4 v) { return (f32x4){sigm(v[0]), sigm(v[1]), sigm(v[2]), sigm(v[3])}; }
__device__ __forceinline__ u32x4 pack8(f32x4 v0, f32x4 v1) { u32x4 w; w.x = cvt_pk_bf16(v0[0], v0[1]); w.y = cvt_pk_bf16(v0[2], v0[3]); w.z = cvt_pk_bf16(v1[0], v1[1]); w.w = cvt_pk_bf16(v1[2], v1[3]); return w; }
__device__ __forceinline__ void unpack8(u32x4 w, f32x4& v0, f32x4& v1) {
    v0 = (f32x4){__uint_as_float(w.x << 16), __uint_as_float(w.x & 0xffff0000u), __uint_as_float(w.y << 16), __uint_as_float(w.y & 0xffff0000u)};
    v1 = (f32x4){__uint_as_float(w.z << 16), __uint_as_float(w.z & 0xffff0000u), __uint_as_float(w.w << 16), __uint_as_float(w.w & 0xffff0000u)};
}

struct EpiProj {
    static constexpr bool PERM = true, AFTER_DRAIN = false;
    bf16_t *UG, *QH, *G; size_t qkv_stride; float qscale;
    __device__ __forceinline__ void operator()(const f32x4 (&acc)[2][2][4][2], const Unit& u, int wr, int wc, int fr, int fq) const {
        const int pn = u.pn, row0 = u.pm * BM + wr * 64 + fr, cw = wc * 32 + 8 * fq;
        if (pn >= 8) {
#pragma unroll
            for (int ai = 0; ai < 2; ++ai)
#pragma unroll
                for (int m = 0; m < 4; ++m) { const int r = row0 + ai * HALF + m * 16; bf16_t* rowp = G + (size_t)r * 2048 + (pn * 256 - 2048) + cw;
#pragma unroll
                    for (int bj = 0; bj < 2; ++bj) *(u32x4*)(rowp + bj * HALF) = pack8(sigm4(acc[ai][bj][m][0]), sigm4(acc[ai][bj][m][1])); }
        } else if (pn >= 2) {
            const int t = (pn - 2) >> 1; bf16_t* base = QH + (size_t)t * qkv_stride; const float sc = t == 0 ? qscale : 1.0f;
#pragma unroll
            for (int ai = 0; ai < 2; ++ai)
#pragma unroll
                for (int m = 0; m < 4; ++m) { const int r = row0 + ai * HALF + m * 16, b = r >> 13, s = r & 8191;
#pragma unroll
                    for (int bj = 0; bj < 2; ++bj) { const int cc = (pn & 1) * 256 + bj * 128 + cw, h = cc >> 6, d = cc & 63;
                        bf16_t* dst = base + ((size_t)((b * 8 + h) * 8192 + s)) * 64 + d;
                        *(u32x4*)dst = pack8(acc[ai][bj][m][0] * sc, acc[ai][bj][m][1] * sc); } }
        } else {
#pragma unroll
            for (int ai = 0; ai < 2; ++ai)
#pragma unroll
                for (int m = 0; m < 4; ++m) { const int r = row0 + ai * HALF + m * 16, b = r >> 13, s = r & 8191;
#pragma unroll
                    for (int bj = 0; bj < 2; ++bj) { const int cc = pn * 256 + bj * 128 + cw, g = cc >> 4;
                        bf16_t* dst = UG + ((size_t)((b * 32 + g) * 8192 + s)) * 16 + (cc & 8);
                        *(u32x4*)dst = pack8(acc[ai][bj][m][0], acc[ai][bj][m][1]); } }
        }
    }
};
struct EpiGlu {
    static constexpr bool PERM = true, AFTER_DRAIN = false;
    const bf16_t* G; bf16_t* T1;
    __device__ __forceinline__ void operator()(const f32x4 (&acc)[2][2][4][2], const Unit& u, int wr, int wc, int fr, int fq) const {
        const int row0 = u.pm * BM + wr * 64 + fr, col = u.pn * 128 + wc * 32 + 8 * fq;
#pragma unroll
        for (int ai = 0; ai < 2; ++ai)
#pragma unroll
            for (int m = 0; m < 4; ++m) { const int r = row0 + ai * HALF + m * 16;
                f32x4 g0, g1; unpack8(*(const u32x4*)(G + (size_t)r * 2048 + col), g0, g1);
                const f32x4 t0 = acc[ai][0][m][0] * sigm4(acc[ai][1][m][0]) * g0, t1 = acc[ai][0][m][1] * sigm4(acc[ai][1][m][1]) * g1;
                *(u32x4*)(T1 + (size_t)r * 1024 + col) = pack8(t0, t1); }
    }
};
struct EpiMerge {
    static constexpr bool PERM = true, AFTER_DRAIN = false;
    const bf16_t* G; const bf16_t* T1; bf16_t* MG;
    __device__ __forceinline__ void operator()(const f32x4 (&acc)[2][2][4][2], const Unit& u, int wr, int wc, int fr, int fq) const {
        const int row0 = u.pm * BM + wr * 64 + fr, col0 = u.pn * BM + wc * 32 + 8 * fq;
#pragma unroll
        for (int ai = 0; ai < 2; ++ai)
#pragma unroll
            for (int m = 0; m < 4; ++m) { const int r = row0 + ai * HALF + m * 16;
#pragma unroll
                for (int bj = 0; bj < 2; ++bj) { const int col = col0 + bj * HALF;
                    f32x4 g0, g1, t0, t1; unpack8(*(const u32x4*)(G + (size_t)r * 2048 + 1024 + col), g0, g1); unpack8(*(const u32x4*)(T1 + (size_t)r * 1024 + col), t0, t1);
                    *(u32x4*)(MG + (size_t)r * 1024 + col) = pack8(t0 + g0 * acc[ai][bj][m][0], t1 + g1 * acc[ai][bj][m][1]); } }
    }
};
struct EpiSwiGlu {
    static constexpr bool PERM = true, AFTER_DRAIN = false;
    bf16_t* H;
    __device__ __forceinline__ void operator()(const f32x4 (&acc)[2][2][4][2], const Unit& u, int wr, int wc, int fr, int fq) const {
        const int row0 = u.pm * BM + wr * 64 + fr, col = u.pn * 128 + wc * 32 + 8 * fq;
#pragma unroll
        for (int ai = 0; ai < 2; ++ai)
#pragma unroll
            for (int m = 0; m < 4; ++m) { const int r = row0 + ai * HALF + m * 16;
                const f32x4 a0 = acc[ai][0][m][0], a1 = acc[ai][0][m][1];
                *(u32x4*)(H + (size_t)r * 2816 + col) = pack8(a0 * sigm4(a0) * acc[ai][1][m][0], a1 * sigm4(a1) * acc[ai][1][m][1]); }
    }
};
struct EpiF32 {
    static constexpr bool PERM = false, AFTER_DRAIN = false;
    float* C; int ldc;
    __device__ __forceinline__ void operator()(const f32x4 (&acc)[2][2][4][2], const Unit& u, int wr, int wc, int fr, int fq) const {
        const int row0 = u.pm * BM + wr * 64 + fr, col0 = u.pn * BM + wc * 32 + 4 * fq;
#pragma unroll
        for (int ai = 0; ai < 2; ++ai)
#pragma unroll
            for (int m = 0; m < 4; ++m) { float* rowp = C + (size_t)(row0 + ai * HALF + m * 16) * ldc + col0;
#pragma unroll
                for (int bj = 0; bj < 2; ++bj)
#pragma unroll
                    for (int n = 0; n < 2; ++n) *(f32x4*)(rowp + bj * HALF + n * 16) = acc[ai][bj][m][n]; }
    }
};
template <class Epi, class Sched, bool ALIGN_EPI = false, bool SP2 = false>
__device__ __forceinline__ void gemm_phase(PG8_LAS unsigned char* lds, const Gemm g, const Sched& S, const Epi& E) {
    const int tid = threadIdx.x, wid = __builtin_amdgcn_readfirstlane(tid >> 6), lane = tid & 63, wr = wid >> 2, wc = wid & 3, fr = lane & 15, fq = lane >> 4;
    const int K = g.K, nt = K / BK;
    unsigned voffA[2], voffB[2];
#pragma unroll
    for (int i = 0; i < 2; ++i) { int R, C; stage_rc(tid * 16 + i * 8192, R, C); const int Rb = Epi::PERM ? ((R & ~31) + perm32(R & 31)) : R;
        voffA[i] = (unsigned)(R * K + C) * 2u; voffB[i] = (unsigned)(Rb * K + C) * 2u; }
    const size_t kstep = (size_t)(BK * 2);
    const size_t hstep = (size_t)HALF * K * 2;
    const size_t tstep = 2 * hstep;
    const unsigned ldsw = (unsigned)wid * 1024u;
    const int aoff = lds_byte(wr * 64 + fr, fq * 8), boff = lds_byte(wc * 32 + fr, fq * 8);
#define PG8_SA(b, h) (((b) * 2 + (h)) * HTB)
#define PG8_SB(b, h) ((4 + (b) * 2 + (h)) * HTB)
#define PG8_STAGE(bufoff, gbase, voff) do { _Pragma("unroll") for (int _i = 0; _i < 2; ++_i) \
        __builtin_amdgcn_global_load_lds((const unsigned*)((const char*)(gbase) + (voff)[_i]), (PG8_LAS unsigned*)(lds + (bufoff) + ldsw + _i * 8192), 16, 0, 0); } while (0)
#define PG8_LDA(dst, b, h) do { _Pragma("unroll") for (int m = 0; m < 4; ++m) _Pragma("unroll") for (int k = 0; k < 2; ++k) dst[m][k] = *(const PG8_LAS bf16x8*)(lds + PG8_SA(b, h) + aoff + m * 2048 + k * 1024); } while (0)
#define PG8_LDB(dst, b, h) do { _Pragma("unroll") for (int n = 0; n < 2; ++n) _Pragma("unroll") for (int k = 0; k < 2; ++k) dst[n][k] = *(const PG8_LAS bf16x8*)(lds + PG8_SB(b, h) + boff + n * 2048 + k * 1024); } while (0)
#define PG8_MMA(ai, bj, At, Bt) do { __builtin_amdgcn_s_setprio(1); _Pragma("unroll") for (int m = 0; m < 4; ++m) _Pragma("unroll") for (int n = 0; n < 2; ++n) _Pragma("unroll") for (int k = 0; k < 2; ++k) \
        acc[ai][bj][m][n] = __builtin_amdgcn_mfma_f32_16x16x32_bf16(Bt[n][k], At[m][k], acc[ai][bj][m][n], 0, 0, 0); __builtin_amdgcn_s_setprio(0); } while (0)
#define PG8_WAIT_V(n) asm volatile("s_waitcnt vmcnt(" #n ")" ::: "memory")
#define PG8_WAIT_L(n) asm volatile("s_waitcnt lgkmcnt(" #n ")" ::: "memory")
#define PG8_BAR __builtin_amdgcn_s_barrier()
#define PG8_SCHED __builtin_amdgcn_sched_barrier(0)
    Unit cur, nxt; int ui = 0;
    if (!S.next(0, cur)) return;
    f32x4 acc[2][2][4][2];
#pragma unroll
    for (int a = 0; a < 2; ++a)
#pragma unroll
        for (int b = 0; b < 2; ++b)
#pragma unroll
            for (int m = 0; m < 4; ++m)
#pragma unroll
                for (int n = 0; n < 2; ++n) acc[a][b][m][n] = (f32x4){0.f, 0.f, 0.f, 0.f};
    bf16x8 At[4][2], B0[2][2], B1[2][2];
    const char* cA = (const char*)g.A + (size_t)cur.pm * tstep; const char* cB = (const char*)g.Bt + (size_t)cur.pn * tstep;
    S.a_ready(cur);
    if constexpr (SP2) {
        PG8_STAGE(PG8_SB(0, 0), cB, voffB); PG8_STAGE(PG8_SB(0, 1), cB + hstep, voffB); PG8_STAGE(PG8_SA(0, 0), cA, voffA); PG8_STAGE(PG8_SA(0, 1), cA + hstep, voffA);
        if (wr == 1) PG8_BAR;
        PG8_WAIT_V(2); PG8_BAR;
        PG8_STAGE(PG8_SB(1, 0), cB + kstep, voffB); PG8_STAGE(PG8_SA(1, 0), cA + kstep, voffA); PG8_STAGE(PG8_SB(1, 1), cB + hstep + kstep, voffB);
        PG8_WAIT_V(6); PG8_BAR;
    } else {
        PG8_STAGE(PG8_SB(0, 0), cB, voffB); PG8_STAGE(PG8_SA(0, 0), cA, voffA); PG8_STAGE(PG8_SB(0, 1), cB + hstep, voffB); PG8_STAGE(PG8_SA(0, 1), cA + hstep, voffA);
        if (wr == 1) PG8_BAR;
        PG8_WAIT_V(4); PG8_BAR;
        PG8_STAGE(PG8_SB(1, 0), cB + kstep, voffB); PG8_STAGE(PG8_SA(1, 0), cA + kstep, voffA); PG8_STAGE(PG8_SB(1, 1), cB + hstep + kstep, voffB);
        PG8_WAIT_V(6); PG8_BAR;
    }
    for (;;) {
        const bool has_next = S.next(ui + 1, nxt);
        const char* nA = has_next ? (const char*)g.A + (size_t)nxt.pm * tstep : cA; const char* nB = has_next ? (const char*)g.Bt + (size_t)nxt.pn * tstep : cB;
        for (int t = 0; t < nt; t += 2) {
            const bool last = (t == nt - 2);
            const char* a1 = cA + (size_t)(t + 1) * kstep;
            const char* a2 = last ? nA : cA + (size_t)(t + 2) * kstep; const char* b2 = last ? nB : cB + (size_t)(t + 2) * kstep;
            const char* a3 = a2 + kstep; const char* b3 = b2 + kstep;
            if (last && has_next) S.a_ready(nxt);
            if constexpr (SP2) {
            PG8_LDB(B0, 0, 0); PG8_LDB(B1, 0, 1); PG8_SCHED; PG8_LDA(At, 0, 0); PG8_STAGE(PG8_SA(1, 1), a1 + hstep, voffA);
            PG8_WAIT_V(8); PG8_WAIT_L(0); PG8_BAR; PG8_MMA(0, 0, At, B0); PG8_MMA(0, 1, At, B1); PG8_BAR; PG8_SCHED;
            PG8_LDA(At, 0, 1); PG8_STAGE(PG8_SB(0, 0), b2, voffB); PG8_STAGE(PG8_SB(0, 1), b2 + hstep, voffB); PG8_STAGE(PG8_SA(0, 0), a2, voffA);
            PG8_WAIT_V(8); PG8_WAIT_L(0); PG8_BAR; PG8_MMA(1, 0, At, B0); PG8_MMA(1, 1, At, B1); PG8_BAR; PG8_SCHED;
            PG8_LDB(B0, 1, 0); PG8_LDB(B1, 1, 1); PG8_SCHED; PG8_LDA(At, 1, 0); PG8_STAGE(PG8_SA(0, 1), a2 + hstep, voffA);
            PG8_WAIT_V(8); PG8_WAIT_L(0); PG8_BAR; PG8_MMA(0, 0, At, B0); PG8_MMA(0, 1, At, B1); PG8_BAR; PG8_SCHED;
            PG8_LDA(At, 1, 1); PG8_STAGE(PG8_SB(1, 0), b3, voffB); PG8_STAGE(PG8_SB(1, 1), b3 + hstep, voffB); PG8_STAGE(PG8_SA(1, 0), a3, voffA);
            PG8_WAIT_V(8); PG8_WAIT_L(0); PG8_BAR; PG8_MMA(1, 0, At, B0); PG8_MMA(1, 1, At, B1); PG8_BAR; PG8_SCHED;
            } else {
            PG8_LDB(B0, 0, 0); PG8_SCHED; PG8_LDA(At, 0, 0); PG8_STAGE(PG8_SA(1, 1), a1 + hstep, voffA);
            PG8_WAIT_L(8); PG8_BAR; PG8_WAIT_L(0); PG8_MMA(0, 0, At, B0); PG8_BAR; PG8_SCHED;
            PG8_LDB(B1, 0, 1); PG8_STAGE(PG8_SB(0, 0), b2, voffB);
            PG8_BAR; PG8_WAIT_L(0); PG8_MMA(0, 1, At, B1); PG8_BAR;
            PG8_LDA(At, 0, 1); PG8_STAGE(PG8_SA(0, 0), a2, voffA);
            PG8_BAR; PG8_WAIT_L(0); PG8_MMA(1, 0, At, B0); PG8_BAR; PG8_SCHED;
            PG8_STAGE(PG8_SB(0, 1), b2 + hstep, voffB);
            PG8_WAIT_V(6); PG8_BAR; PG8_MMA(1, 1, At, B1); PG8_BAR;
            PG8_LDB(B0, 1, 0); PG8_SCHED; PG8_LDA(At, 1, 0); PG8_STAGE(PG8_SA(0, 1), a2 + hstep, voffA);
            PG8_WAIT_L(8); PG8_BAR; PG8_WAIT_L(0); PG8_MMA(0, 0, At, B0); PG8_BAR; PG8_SCHED;
            PG8_LDB(B1, 1, 1); PG8_STAGE(PG8_SB(1, 0), b3, voffB);
            PG8_BAR; PG8_WAIT_L(0); PG8_MMA(0, 1, At, B1); PG8_BAR;
            PG8_LDA(At, 1, 1); PG8_STAGE(PG8_SA(1, 0), a3, voffA);
            PG8_BAR; PG8_WAIT_L(0); PG8_MMA(1, 0, At, B0); PG8_BAR; PG8_SCHED;
            PG8_STAGE(PG8_SB(1, 1), b3 + hstep, voffB);
            PG8_WAIT_V(6); PG8_BAR; PG8_MMA(1, 1, At, B1); PG8_BAR;
            }
        }
        if constexpr (ALIGN_EPI) { if (wr == 0) PG8_BAR; }
        if constexpr (!Epi::AFTER_DRAIN) { E(acc, cur, wr, wc, fr, fq); S.done(cur); }
        if (!has_next) break;
#pragma unroll
        for (int a = 0; a < 2; ++a)
#pragma unroll
            for (int b = 0; b < 2; ++b)
#pragma unroll
                for (int m = 0; m < 4; ++m)
#pragma unroll
                    for (int n = 0; n < 2; ++n) acc[a][b][m][n] = (f32x4){0.f, 0.f, 0.f, 0.f};
        cur = nxt; cA = nA; cB = nB; ++ui;
        if constexpr (ALIGN_EPI) { if (wr == 1) PG8_BAR; }
    }
    PG8_WAIT_V(0);
    if constexpr (!ALIGN_EPI) { if (wr == 0) PG8_BAR; }
    PG8_BAR;
    if constexpr (Epi::AFTER_DRAIN) { E.fused(acc, cur, wr, wc, fr, fq, lds, wid, lane); S.done(cur); }
#undef PG8_SA
#undef PG8_SB
#undef PG8_STAGE
#undef PG8_LDA
#undef PG8_LDB
#undef PG8_MMA
#undef PG8_WAIT_V
#undef PG8_WAIT_L
#undef PG8_BAR
#undef PG8_SCHED
}
}
#define GAS __attribute__((address_space(1)))
#define LAS __attribute__((address_space(3)))
typedef unsigned short bf16;
typedef unsigned v4u __attribute__((ext_vector_type(4)));
typedef float f32x4 __attribute__((ext_vector_type(4)));
typedef short bf16x8 __attribute__((ext_vector_type(8)));
typedef GAS unsigned gu32;
typedef GAS unsigned long long gu64;
#define RLX_AGENT __ATOMIC_RELAXED, __HIP_MEMORY_SCOPE_AGENT
#define LDS_WAIT() asm volatile("s_waitcnt lgkmcnt(0)" ::: "memory")
#define VM_WAIT() asm volatile("s_waitcnt vmcnt(0)" ::: "memory")
__device__ __forceinline__ unsigned long long rt() { return __builtin_amdgcn_s_memrealtime(); }
__device__ __forceinline__ unsigned f2bf(float f) { unsigned u = __builtin_bit_cast(unsigned, f); return (u + 0x7fffu + ((u >> 16) & 1u)) >> 16; }
__device__ __forceinline__ unsigned pk2(float lo, float hi) { return f2bf(lo) | (f2bf(hi) << 16); }

#define XB_TMO      128
#define XB_XCNT(j)  (256  + 64 * (j))
#define XB_XSUB(j)  (1280 + 64 * (j))
#define XB_XGEN(j)  (2304 + 64 * (j))
#define XB_TOP      3328
#define XB_TOPGEN   3392
#define XCD_BAR_WORDS 3456
#define XB_SPIN_CAP (1u << 18)

__device__ __forceinline__ unsigned xb_ld(unsigned* p)              { return __hip_atomic_load(p, __ATOMIC_RELAXED, __HIP_MEMORY_SCOPE_AGENT); }
__device__ __forceinline__ unsigned xb_add(unsigned* p, unsigned v) { return __hip_atomic_fetch_add(p, v, __ATOMIC_RELAXED, __HIP_MEMORY_SCOPE_AGENT); }
__device__ __forceinline__ unsigned xb_xcc_id() { return (unsigned)__builtin_amdgcn_s_getreg((3 << 11) | 20) & 0xFu; }
#define XB_SPIN(cond, bar) do { unsigned _sp = 0; while (cond) { __builtin_amdgcn_s_sleep(1); \
    if ((++_sp & 255u) == 0u) { if (xb_ld(&(bar)[XB_TMO])) break; if (_sp > XB_SPIN_CAP) { atomicAdd(&(bar)[XB_TMO], 1u); break; } } } } while (0)

struct XcdBarrier {
    unsigned* bar; unsigned x;
    volatile LAS unsigned* st;
};

__device__ __forceinline__ XcdBarrier xcd_barrier_post(unsigned* bar, volatile LAS unsigned* st) {
    XcdBarrier b; b.bar = bar; b.x = xb_xcc_id(); b.st = st;
    if (threadIdx.x == 0) (void)xb_add(&bar[XB_XCNT(b.x)], 1u);
    return b;
}
__device__ __forceinline__ void xcd_barrier_complete(unsigned* bar, unsigned x, unsigned& nloc, unsigned& nx) {
    const unsigned G = gridDim.x * gridDim.y * gridDim.z;
    unsigned sum, cnt, mine, sp = 0u;
    for (;;) {
        sum = 0u; cnt = 0u; mine = 0u;
#pragma unroll
        for (unsigned j = 0; j < 16; ++j) { const unsigned c = xb_ld(&bar[XB_XCNT(j)]); sum += c; cnt += (c > 0u) ? 1u : 0u; mine = (j == x) ? c : mine; }
        if (sum == G) break;
        __builtin_amdgcn_s_sleep(1);
        if ((++sp & 255u) == 0u) { if (xb_ld(&bar[XB_TMO])) break; if (sp > XB_SPIN_CAP) { atomicAdd(&bar[XB_TMO], 1u); break; } }
    }
    nloc = mine > 0u ? mine : 1u; nx = cnt > 0u ? cnt : 1u;
}

__device__ __forceinline__ void xcd_barrier(const XcdBarrier& b) {
    asm volatile("s_waitcnt vmcnt(0)" ::: "memory");
    __syncthreads();
    if (threadIdx.x == 0) {
        unsigned* bar = b.bar;
        __builtin_amdgcn_s_waitcnt(0);
        unsigned nloc = b.st[0], nx = b.st[1];
        if (nloc == 0u) { xcd_barrier_complete(bar, b.x, nloc, nx); b.st[0] = nloc; b.st[1] = nx; }
        const unsigned old = xb_add(&bar[XB_XSUB(b.x)], 1u);
        const unsigned gen = old / nloc;
        if (old + 1u == (gen + 1u) * nloc) {
            __builtin_amdgcn_fence(__ATOMIC_RELEASE, "agent");
            asm volatile("s_waitcnt vmcnt(0)" ::: "memory");
            const unsigned og = xb_add(&bar[XB_TOP], 1u);
            const unsigned tg = og / nx;
            if (og + 1u == (tg + 1u) * nx) xb_add(&bar[XB_TOPGEN], 1u);
            else XB_SPIN(xb_ld(&bar[XB_TOPGEN]) == tg, bar);
            __builtin_amdgcn_fence(__ATOMIC_ACQUIRE, "agent");
            xb_add(&bar[XB_XGEN(b.x)], 1u);
            asm volatile("s_waitcnt vmcnt(0)" ::: "memory");
        } else {
            XB_SPIN(xb_ld(&bar[XB_XGEN(b.x)]) == gen, bar);
            __builtin_amdgcn_fence(__ATOMIC_ACQUIRE, "agent");
            asm volatile("s_waitcnt vmcnt(0)" ::: "memory");
        }
    }
    __syncthreads();
}

constexpr size_t MiB = 1u << 20;
constexpr size_t WS_CTL = 0, CTL_ZERO_BYTES = 1 * MiB;
constexpr int CW_BAR = 4096;
constexpr size_t WS_MOD = 1 * MiB;
constexpr size_t WS_KMEAN = 1 * MiB + 256 * 1024;
constexpr size_t WS_SSMT = 2 * MiB;
constexpr size_t WS_WIN = 28 * MiB, WS_WGLU = 36 * MiB, WS_WAO = 38 * MiB, WS_WOUT = 39 * MiB, WS_WGU = 41 * MiB, WS_WDN = 52 * MiB;
constexpr size_t WS_HN = 58 * MiB;
constexpr size_t WS_UG = 122 * MiB, WS_QH = 154 * MiB, WS_KH = 186 * MiB, WS_VH = 218 * MiB, WS_VT = 250 * MiB;
constexpr size_t WS_G = 282 * MiB;
constexpr size_t WS_Z = 410 * MiB, WS_O = 442 * MiB;
constexpr size_t WS_T1 = 122 * MiB;
constexpr size_t WS_MG = 186 * MiB;
constexpr size_t WS_H = 122 * MiB;
constexpr size_t WS_Y1 = 282 * MiB;
constexpr size_t WS_Y2 = 298 * MiB;
constexpr size_t WS_END = 474 * MiB;

constexpr int RING_OFF = 0, RING_BYTES = 131072;
constexpr int LDS_BYTES = 163840;
constexpr int LDSCTL_OFF = LDS_BYTES - 512, MISC_OFF = LDSCTL_OFF + 320;
constexpr int NWAVES = 8, NTHREADS = 512;

__device__ __forceinline__ float bf2f(bf16 b) { return __uint_as_float(((unsigned)b) << 16); }
__device__ __forceinline__ float wave_sum(float v) {
#pragma unroll
    for (int o = 1; o < 64; o <<= 1) v += __shfl_xor(v, o);
    return v;
}
__device__ __forceinline__ float wave_max(float v) {
#pragma unroll
    for (int o = 1; o < 64; o <<= 1) v = fmaxf(v, __shfl_xor(v, o));
    return v;
}


namespace moba {
typedef short bf16x8 __attribute__((ext_vector_type(8)));
typedef float f32x16 __attribute__((ext_vector_type(16)));
typedef unsigned u32x4 __attribute__((ext_vector_type(4)));
typedef short v4i16_t __attribute__((ext_vector_type(4)));
constexpr int A_Q = 0, A_PO = 32768, A_PM = 131072, A_PL = 135168, A_SEL = 139264, A_CNT = 140288, A_ITEM = 140544, A_LIST = 140672, A_WSF = 157056, A_END = 159104;
__device__ __forceinline__ int opq(int v) { asm volatile("" : "+v"(v)); return v; }
__device__ __forceinline__ int crow(int r, int hi) { return (r & 3) + 8 * (r >> 2) + 4 * hi; }
__device__ __forceinline__ float rowmax32(const f32x16& p0, const f32x16& p1) {
    float a = fmaxf(fmaxf(p0[0], p0[1]), p1[0]), b = fmaxf(fmaxf(p0[2], p0[3]), p1[1]); a = fmaxf(fmaxf(a, p1[2]), p1[3]);
#pragma unroll
    for (int r = 4; r < 16; r += 4) { a = fmaxf(fmaxf(a, p0[r]), p0[r + 1]); b = fmaxf(fmaxf(b, p0[r + 2]), p0[r + 3]); a = fmaxf(fmaxf(a, p1[r]), p1[r + 1]); b = fmaxf(fmaxf(b, p1[r + 2]), p1[r + 3]); }
    const float m = fmaxf(a, b);
    auto rr = __builtin_amdgcn_permlane32_swap(__float_as_uint(m), __float_as_uint(m), false, false);
    return fmaxf(__uint_as_float(rr[0]), __uint_as_float(rr[1]));
}
__device__ __forceinline__ float halves_sum(float v) { auto rr = __builtin_amdgcn_permlane32_swap(__float_as_uint(v), __float_as_uint(v), false, false); return __uint_as_float(rr[0]) + __uint_as_float(rr[1]); }
__device__ __forceinline__ unsigned pk(float lo, float hi) { return pg8::cvt_pk_bf16(lo, hi); }

template <bool MASK>
__device__ __forceinline__ void tile_pass(const bf16* __restrict__ Kb, const bf16* __restrict__ Vt, int kblk, int nt, const LAS unsigned char* qrow, int qsw, int qi, float tq, float sl2_,
                                          int r32, int hi, LAS float* wsf, f32x16 (&o)[2], float& mhat_out, float& l_out) {
    o[0] = f32x16{}; o[1] = f32x16{};
    float mhat = 0.f, l = 0.f;
    const GAS bf16* kp = (const GAS bf16*)Kb + (size_t)(kblk * 256 + r32) * 64 + 8 * hi;
    const GAS bf16* vp = (const GAS bf16*)Vt + (size_t)r32 * 8192 + kblk * 256 + 8 * hi;
    bf16x8 kf[8];
#pragma unroll
    for (int d0 = 0; d0 < 4; ++d0) { kf[2 * d0] = *(const GAS bf16x8*)(kp + 16 * d0); kf[2 * d0 + 1] = *(const GAS bf16x8*)(kp + 32 * 64 + 16 * d0); }
#pragma unroll 1
    for (int kt = 0; kt < nt; ++kt) {
        bf16x8 vf[8];
#pragma unroll
        for (int ks = 0; ks < 4; ++ks) { vf[ks] = *(const GAS bf16x8*)(vp + 64 * kt + 16 * ks); vf[4 + ks] = *(const GAS bf16x8*)(vp + (size_t)32 * 8192 + 64 * kt + 16 * ks); }
        float sl2 = sl2_; asm volatile("" : "+v"(sl2) :: "memory");
        bf16x8 qr[4];
#pragma unroll
        for (int d0 = 0; d0 < 4; ++d0) qr[d0] = *(const LAS bf16x8*)(qrow + (((2 * d0) ^ qsw) << 4));
        const float cb = sl2 * ((float)(kblk * 256 + 64 * kt + 4 * hi) - tq) - mhat;
        f32x16 p0, p1;
#pragma unroll
        for (int r = 0; r < 16; ++r) { p0[r] = cb + sl2 * (float)((r & 3) + 8 * (r >> 2)); p1[r] = p0[r] + 32.0f * sl2; }
#pragma unroll
        for (int d0 = 0; d0 < 4; ++d0) { p0 = __builtin_amdgcn_mfma_f32_32x32x16_bf16(kf[2 * d0], qr[d0], p0, 0, 0, 0); p1 = __builtin_amdgcn_mfma_f32_32x32x16_bf16(kf[2 * d0 + 1], qr[d0], p1, 0, 0, 0); }
        if (kt + 1 < nt) {
#pragma unroll
            for (int d0 = 0; d0 < 4; ++d0) { kf[2 * d0] = *(const GAS bf16x8*)(kp + (size_t)(64 * (kt + 1)) * 64 + 16 * d0); kf[2 * d0 + 1] = *(const GAS bf16x8*)(kp + (size_t)(64 * (kt + 1) + 32) * 64 + 16 * d0); }
        }
        if (MASK) { const int kb = 64 * kt + 4 * hi;
#pragma unroll
            for (int r = 0; r < 16; ++r) { const int kk = kb + (r & 3) + 8 * (r >> 2); if (kk > qi) p0[r] = -INFINITY; if (kk + 32 > qi) p1[r] = -INFINITY; } }
        const float rm = rowmax32(p0, p1);
        if (kt == 0) {
            mhat = rm;
#pragma unroll
            for (int r = 0; r < 16; ++r) { p0[r] -= rm; p1[r] -= rm; }
        } else if (__any(rm > 0.f)) {
            const float dl = fmaxf(rm, 0.f); mhat += dl;
#pragma unroll
            for (int r = 0; r < 16; ++r) { p0[r] -= dl; p1[r] -= dl; }
            const float f = __builtin_amdgcn_exp2f(-dl); l *= f;
            if (hi == 0) wsf[r32] = f;
            asm volatile("s_waitcnt lgkmcnt(0)" ::: "memory");
#pragma unroll
            for (int r = 0; r < 16; ++r) { const float fr_ = wsf[crow(r, hi)]; o[0][r] *= fr_; o[1][r] *= fr_; }
            asm volatile("s_waitcnt lgkmcnt(0)" ::: "memory");
        }
        float sacc = 0.f;
#pragma unroll
        for (int r = 0; r < 16; ++r) { p0[r] = __builtin_amdgcn_exp2f(p0[r]); p1[r] = __builtin_amdgcn_exp2f(p1[r]); sacc += p0[r] + p1[r]; }
        l += sacc;
        u32x4 pw0 = {pk(p0[0], p0[1]), pk(p0[2], p0[3]), pk(p0[4], p0[5]), pk(p0[6], p0[7])}, pw1 = {pk(p0[8], p0[9]), pk(p0[10], p0[11]), pk(p0[12], p0[13]), pk(p0[14], p0[15])};
        u32x4 pw2 = {pk(p1[0], p1[1]), pk(p1[2], p1[3]), pk(p1[4], p1[5]), pk(p1[6], p1[7])}, pw3 = {pk(p1[8], p1[9]), pk(p1[10], p1[11]), pk(p1[12], p1[13]), pk(p1[14], p1[15])};
        o[0] = __builtin_amdgcn_mfma_f32_32x32x16_bf16(__builtin_bit_cast(bf16x8, pw0), vf[0], o[0], 0, 0, 0); o[1] = __builtin_amdgcn_mfma_f32_32x32x16_bf16(__builtin_bit_cast(bf16x8, pw0), vf[4], o[1], 0, 0, 0);
        o[0] = __builtin_amdgcn_mfma_f32_32x32x16_bf16(__builtin_bit_cast(bf16x8, pw1), vf[1], o[0], 0, 0, 0); o[1] = __builtin_amdgcn_mfma_f32_32x32x16_bf16(__builtin_bit_cast(bf16x8, pw1), vf[5], o[1], 0, 0, 0);
        o[0] = __builtin_amdgcn_mfma_f32_32x32x16_bf16(__builtin_bit_cast(bf16x8, pw2), vf[2], o[0], 0, 0, 0); o[1] = __builtin_amdgcn_mfma_f32_32x32x16_bf16(__builtin_bit_cast(bf16x8, pw2), vf[6], o[1], 0, 0, 0);
        o[0] = __builtin_amdgcn_mfma_f32_32x32x16_bf16(__builtin_bit_cast(bf16x8, pw3), vf[3], o[0], 0, 0, 0); o[1] = __builtin_amdgcn_mfma_f32_32x32x16_bf16(__builtin_bit_cast(bf16x8, pw3), vf[7], o[1], 0, 0, 0);
    }
    mhat_out = mhat; l_out = halves_sum(l);
}

__device__ __forceinline__ void attn_phase(LAS unsigned char* lds, int tid_, int vcu, int G, const bf16* QH, const bf16* KH, const bf16* VT, const float* KM, bf16* O) {
    const int w = __builtin_amdgcn_readfirstlane(tid_ >> 6);
    LAS unsigned char* Qs = lds + A_Q; LAS bf16* Po = (LAS bf16*)(lds + A_PO); LAS float* KMs = (LAS float*)(lds + A_PO);
    LAS float* Pm = (LAS float*)(lds + A_PM); LAS float* Pl = (LAS float*)(lds + A_PL); LAS unsigned char* sel = lds + A_SEL;
    LAS int* cnt = (LAS int*)(lds + A_CNT); LAS int* nitems_p = cnt + 32; LAS int* counter_p = cnt + 33;
    LAS unsigned short* items = (LAS unsigned short*)(lds + A_ITEM); LAS unsigned short* lists = (LAS unsigned short*)(lds + A_LIST);
    LAS float* wsf = (LAS float*)(lds + A_WSF) + w * 64;
    for (int ui = vcu; ui < NB * NH * NBLK; ui += G) {
        const int bh = ui >> 5, qb = (ui + 11 * (ui >> 8)) & 31, h = bh & 7, b = bh >> 3;
        const float sl2 = __builtin_amdgcn_exp2f(-(float)(h + 1)) * LOG2E;
        const bf16* Qb = QH + ((size_t)bh * SEQ + qb * 256) * 64; const bf16* Kb = KH + (size_t)bh * SEQ * 64; const bf16* Vt = VT + (size_t)bh * 64 * SEQ;
        __syncthreads();
        { const int tid = opq(tid_);
#pragma unroll
        for (int i = 0; i < 4; ++i) { const int idx = tid + 512 * i, row = idx >> 3, c = idx & 7;
            *(LAS u32x4*)(Qs + row * 128 + ((c ^ (row & 7)) << 4)) = *(const GAS u32x4*)(Qb + row * 64 + c * 8); }
        for (int i = tid; i < qb * 64; i += NTHREADS) KMs[i] = KM[(size_t)bh * 32 * 64 + i];
        if (tid < 32) cnt[tid] = 0;
        if (tid == 32) { *counter_p = 0; *nitems_p = 0; }
        }
        __syncthreads();
        const int nsel = qb < 3 ? qb : 3;
        { const int tid = opq(tid_);
        if (tid < 256 && qb > 0) {
            float qv[64];
#pragma unroll
            for (int c = 0; c < 8; ++c) { const u32x4 wv = *(const LAS u32x4*)(Qs + tid * 128 + ((c ^ (tid & 7)) << 4));
                qv[8 * c + 0] = __uint_as_float(wv.x << 16); qv[8 * c + 1] = __uint_as_float(wv.x & 0xffff0000u); qv[8 * c + 2] = __uint_as_float(wv.y << 16); qv[8 * c + 3] = __uint_as_float(wv.y & 0xffff0000u);
                qv[8 * c + 4] = __uint_as_float(wv.z << 16); qv[8 * c + 5] = __uint_as_float(wv.z & 0xffff0000u); qv[8 * c + 6] = __uint_as_float(wv.w << 16); qv[8 * c + 7] = __uint_as_float(wv.w & 0xffff0000u); }
            float v0 = -INFINITY, v1 = -INFINITY, v2 = -INFINITY; int i0 = 255, i1 = 255, i2 = 255;
            for (int j = 0; j < qb; ++j) {
                float s0 = 0.f, s1 = 0.f;
#pragma unroll
                for (int d = 0; d < 64; d += 8) { const f32x4 ka = *(const LAS f32x4*)(KMs + j * 64 + d), kb2 = *(const LAS f32x4*)(KMs + j * 64 + d + 4);
                    s0 += qv[d] * ka.x + qv[d + 1] * ka.y + qv[d + 2] * ka.z + qv[d + 3] * ka.w; s1 += qv[d + 4] * kb2.x + qv[d + 5] * kb2.y + qv[d + 6] * kb2.z + qv[d + 7] * kb2.w; }
                const float s = s0 + s1;
                if (s > v0) { v2 = v1; i2 = i1; v1 = v0; i1 = i0; v0 = s; i0 = j; }
                else if (s > v1) { v2 = v1; i2 = i1; v1 = s; i1 = j; }
                else if (s > v2) { v2 = s; i2 = j; }
            }
            *(LAS unsigned*)(sel + tid * 4) = (unsigned)i0 | ((unsigned)i1 << 8) | ((unsigned)i2 << 16) | 0xff000000u;
        }
        }
        __syncthreads();
        { const int lane = opq(tid_) & 63;
        for (int j = w; j < qb; j += 8) {
            int base = 0;
#pragma unroll
            for (int c = 0; c < 4; ++c) { const int q = 64 * c + lane; const unsigned s3 = *(const LAS unsigned*)(sel + q * 4);
                const int a0 = s3 & 255, a1 = (s3 >> 8) & 255, a2 = (s3 >> 16) & 255; const bool hit = (a0 == j) | (a1 == j) | (a2 == j); const int slot = (a0 == j) ? 0 : ((a1 == j) ? 1 : 2);
                const unsigned long long mask = __ballot(hit); const int pre = __builtin_amdgcn_mbcnt_hi((unsigned)(mask >> 32), __builtin_amdgcn_mbcnt_lo((unsigned)mask, 0u));
                if (hit) lists[j * 256 + base + pre] = (unsigned short)(q | (slot << 8));
                base += __builtin_popcountll(mask); }
            if (lane == 0) cnt[j] = base;
        }
        }
        __syncthreads();
        if (tid_ == 0) { int n = 0; for (int j = 0; j < qb; ++j) { const int c = cnt[j]; for (int t = 0; t * 32 < c; ++t) items[n++] = (unsigned short)(j | (t << 8)); } *nitems_p = n; }
        __syncthreads();
        const int nitems = *nitems_p;
        for (;;) {
            const int lane = opq(tid_) & 63, r32 = lane & 31, hi = lane >> 5;
            int it = 0; if (lane == 0) it = __hip_atomic_fetch_add(counter_p, 1, __ATOMIC_RELAXED, __HIP_MEMORY_SCOPE_WORKGROUP);
            it = __builtin_amdgcn_readfirstlane(it);
            if (it >= nitems) break;
            const int item = items[it], j = item & 255, tl = item >> 8; int n = cnt[j] - 32 * tl; n = n > 32 ? 32 : n; const int e0 = j * 256 + 32 * tl;
            const int ent = lists[e0 + (r32 < n ? r32 : 0)], qi = ent & 255, slot = ent >> 8;
            f32x16 o[2]; float mh, ls;
            tile_pass<false>(Kb, Vt, j, 4, Qs + qi * 128, hi ^ (qi & 7), qi, (float)(qb * 256 + qi), sl2, r32, hi, wsf, o, mh, ls);
#pragma unroll
            for (int r = 0; r < 16; ++r) { const int ql = crow(r, hi);
                if (ql < n) { const int e2 = lists[e0 + ql]; LAS bf16* dst = Po + ((e2 & 255) * 3 + (e2 >> 8)) * 64 + r32;
                    dst[0] = (bf16)(pk(o[0][r], 0.f) & 0xffffu); dst[32] = (bf16)(pk(o[1][r], 0.f) & 0xffffu); }
                if ((r & 3) == 3) asm volatile("" ::: "memory"); }
            if (hi == 0 && r32 < n) { Pm[qi * 4 + slot] = mh; Pl[qi * 4 + slot] = ls; }
        }
        f32x16 o[2]; float mown, lown;
        { const int lane = opq(tid_) & 63, r32 = lane & 31, hi = lane >> 5; const int qi = 32 * w + r32;
            tile_pass<true>(Kb, Vt, qb, (w >> 1) + 1, Qs + qi * 128, hi ^ (qi & 7), qi, (float)(qb * 256 + qi), sl2, r32, hi, wsf, o, mown, lown); }
        __syncthreads();
        const int lane = opq(tid_) & 63, r32 = lane & 31, hi = lane >> 5;
        if (hi == 0) { wsf[r32] = mown; wsf[32 + r32] = lown; }
        asm volatile("s_waitcnt lgkmcnt(0)" ::: "memory");
        bf16* Ob = O + ((size_t)b * SEQ + qb * 256 + 32 * w) * 512 + h * 64 + r32;
#pragma unroll
        for (int r = 0; r < 16; ++r) { const int ql = crow(r, hi), q = 32 * w + ql;
            const float mo = wsf[ql], lo = wsf[32 + ql];
            float m0 = -INFINITY, m1 = -INFINITY, m2 = -INFINITY, l0 = 0.f, l1 = 0.f, l2 = 0.f, a0 = 0.f, a1 = 0.f, a2 = 0.f, c0 = 0.f, c1 = 0.f, c2 = 0.f;
            if (nsel > 0) { m0 = Pm[q * 4 + 0]; l0 = Pl[q * 4 + 0]; a0 = bf2f(Po[(q * 3 + 0) * 64 + r32]); c0 = bf2f(Po[(q * 3 + 0) * 64 + 32 + r32]); }
            if (nsel > 1) { m1 = Pm[q * 4 + 1]; l1 = Pl[q * 4 + 1]; a1 = bf2f(Po[(q * 3 + 1) * 64 + r32]); c1 = bf2f(Po[(q * 3 + 1) * 64 + 32 + r32]); }
            if (nsel > 2) { m2 = Pm[q * 4 + 2]; l2 = Pl[q * 4 + 2]; a2 = bf2f(Po[(q * 3 + 2) * 64 + r32]); c2 = bf2f(Po[(q * 3 + 2) * 64 + 32 + r32]); }
            const float mm = fmaxf(fmaxf(mo, m0), fmaxf(m1, m2));
            const float wo = __builtin_amdgcn_exp2f(mo - mm), w0 = __builtin_amdgcn_exp2f(m0 - mm), w1 = __builtin_amdgcn_exp2f(m1 - mm), w2 = __builtin_amdgcn_exp2f(m2 - mm);
            const float ltot = wo * lo + w0 * l0 + w1 * l1 + w2 * l2, inv = 1.0f / ltot;
            const float x0 = (wo * o[0][r] + w0 * a0 + w1 * a1 + w2 * a2) * inv, x1 = (wo * o[1][r] + w0 * c0 + w1 * c1 + w2 * c2) * inv;
            Ob[(size_t)ql * 512] = (bf16)f2bf(x0); Ob[(size_t)ql * 512 + 32] = (bf16)f2bf(x1);
            if (r & 1) asm volatile("" ::: "memory"); }
    }
}

__device__ __forceinline__ void kmean_vt_phase(LAS unsigned char* lds, int tid, int vcu, int G, const bf16* KH, const bf16* VH, float* KM, bf16* VT) {
    const int lane = tid & 63, w = __builtin_amdgcn_readfirstlane(tid >> 6), gw = vcu * 8 + w, NGW = G * 8;
    for (int u = gw; u < NB * NH * NBLK; u += NGW) {
        const bf16* kp = KH + (size_t)u * MBLK * 64 + lane; float s = 0.f;
#pragma unroll 8
        for (int k = 0; k < MBLK; ++k) s += bf2f(kp[k * 64]);
        KM[u * 64 + lane] = s * (1.0f / 256.0f);
    }
    LAS unsigned char* tile = lds + w * 8192;
    for (int u = gw; u < NB * NH * (SEQ / 64); u += NGW) {
        const int bh = u >> 7, kg = u & 127;
        const bf16* vp = VH + ((size_t)bh * SEQ + kg * 64) * 64;
#pragma unroll
        for (int i = 0; i < 8; ++i) { const int idx = lane + 64 * i, row = idx >> 3, c = idx & 7; *(LAS u32x4*)(tile + row * 128 + c * 16) = *(const GAS u32x4*)(vp + row * 64 + c * 8); }
        asm volatile("s_waitcnt lgkmcnt(0)" ::: "memory");
        const int gg = lane >> 4, q4 = (lane >> 2) & 3, p4 = lane & 3;
        bf16* vt = VT + ((size_t)bh * 64 + lane) * SEQ + kg * 64;
#pragma unroll
        for (int g16 = 0; g16 < 4; ++g16) {
            v4i16_t t[4];
#pragma unroll
            for (int k4 = 0; k4 < 4; ++k4) t[k4] = __builtin_amdgcn_ds_read_tr16_b64_v4i16((LAS v4i16_t*)(tile + (g16 * 16 + k4 * 4 + q4) * 128 + (gg * 16 + p4 * 4) * 2));
            typedef short s16x8 __attribute__((ext_vector_type(8)));
            const s16x8 lo = {t[0][0], t[0][1], t[0][2], t[0][3], t[2][0], t[2][1], t[2][2], t[2][3]}, hi8 = {t[1][0], t[1][1], t[1][2], t[1][3], t[3][0], t[3][1], t[3][2], t[3][3]};
            *(GAS s16x8*)(vt + g16 * 16) = lo; *(GAS s16x8*)(vt + g16 * 16 + 8) = hi8;
        }
        asm volatile("s_waitcnt lgkmcnt(0)" ::: "memory");
    }
}
}

namespace s5 {
typedef short bf16x8 __attribute__((ext_vector_type(8)));
constexpr int T_WE = 0, T_WX = 131072, T_KC = 262144, T_ABL = 262144 + 16896, T_STRIDE = 286720;
constexpr int S_KC = 0, S_US = 17408, S_ES = 83968, S_XS = 117760;
constexpr int US_ROW = 1040, ES_ROW = 132, XS_ROW = 272;

__device__ __forceinline__ void ssm_tables(LAS unsigned char* lds, int tid, int g, const float* a_re, const float* a_im, const float* log_dt, const float* b_re, const float* b_im,
                                           const float* c_re, const float* c_im, const float* dsk, unsigned char* tab) {
    LAS float* pwr = (LAS float*)lds; LAS float* pwi = pwr + 33 * 64; LAS float* bbr = pwi + 33 * 64; LAS float* bbi = bbr + 1024; LAS float* cr = bbi + 1024; LAS float* ci = cr + 1024;
    __syncthreads();
    if (tid < 64) { const int p = tid;
        const float dt = expf(log_dt[g]), are = a_re[g * 64 + p], aim = a_im[g * 64 + p];
        const float mag = expf(dt * are), abr = mag * cosf(dt * aim), abi = mag * sinf(dt * aim);
        const float den = are * are + aim * aim, nr = abr - 1.0f, cor = (nr * are + abi * aim) / den, coi = (abi * are - nr * aim) / den;
        float xr = 1.0f, xi = 0.0f;
        for (int n = 0; n <= 32; ++n) { pwr[n * 64 + p] = xr; pwi[n * 64 + p] = xi; const float nxr = xr * abr - xi * abi, nxi = xr * abi + xi * abr; xr = nxr; xi = nxi; }
        for (int c = 0; c < 16; ++c) { const float br = b_re[(g * 64 + p) * 16 + c], bi = b_im[(g * 64 + p) * 16 + c]; bbr[p * 16 + c] = cor * br - coi * bi; bbi[p * 16 + c] = cor * bi + coi * br; }
    }
    for (int i = tid; i < 1024; i += NTHREADS) { cr[i] = c_re[g * 1024 + i]; ci[i] = c_im[g * 1024 + i]; }
    __syncthreads();
    bf16* WE = (bf16*)(tab + T_WE); bf16* WX = (bf16*)(tab + T_WX); bf16* KC = (bf16*)(tab + T_KC); float* ABL = (float*)(tab + T_ABL);
    for (int idx = tid; idx < 128 * 512; idx += NTHREADS) { const int n = idx >> 9, k = idx & 511, s = k >> 4, c = k & 15, p = n & 63;
        const float pr = pwr[(31 - s) * 64 + p], pi = pwi[(31 - s) * 64 + p], br = bbr[p * 16 + c], bi = bbi[p * 16 + c];
        WE[idx] = (bf16)f2bf(n < 64 ? pr * br - pi * bi : pr * bi + pi * br); }
    for (int idx = tid; idx < 512 * 128; idx += NTHREADS) { const int row = idx >> 7, n = idx & 127, tau = row >> 4, c = row & 15, p = n & 63;
        const float pr = pwr[(tau + 1) * 64 + p], pi = pwi[(tau + 1) * 64 + p], xr = cr[c * 64 + p], xi = ci[c * 64 + p];
        WX[idx] = (bf16)f2bf(n < 64 ? xr * pr - xi * pi : -(xr * pi + xi * pr)); }
    { const int cc = tid & 255, c = cc >> 4, c2 = cc & 15, half = tid >> 8;
        float acc[16];
#pragma unroll
        for (int q = 0; q < 16; ++q) acc[q] = 0.f;
        for (int p = 0; p < 64; ++p) { const float xr = cr[c * 64 + p], xi = ci[c * 64 + p], br = bbr[p * 16 + c2], bi = bbi[p * 16 + c2], zr = xr * br - xi * bi, zi = xr * bi + xi * br;
#pragma unroll
            for (int q = 0; q < 16; ++q) acc[q] += zr * pwr[(half * 16 + q) * 64 + p] - zi * pwi[(half * 16 + q) * 64 + p]; }
        if (half == 0 && c == c2) acc[0] += dsk[g * 16 + c];
#pragma unroll
        for (int q = 0; q < 16; ++q) KC[(1 + half * 16 + q) * 256 + cc] = (bf16)f2bf(acc[q]);
        if (tid < 256) KC[tid] = 0; }
    if (tid < 64) { ABL[tid] = pwr[32 * 64 + tid]; ABL[64 + tid] = pwi[32 * 64 + tid]; }
    __syncthreads();
}

__device__ __forceinline__ float gelu_t(float y) {
    const float a = 0.7978845608028654f * (y + 0.044715f * y * y * y);
    const float e = __builtin_amdgcn_exp2f(2.0f * LOG2E * a);
    const float t = 1.0f - 2.0f * __builtin_amdgcn_rcpf(e + 1.0f);
    return 0.5f * y * (1.0f + t);
}

__device__ __forceinline__ void ssm_unit(LAS unsigned char* lds, int tid_, int b, int g, const bf16* UG, const unsigned char* tab, bf16* Z) {
    const int w = __builtin_amdgcn_readfirstlane(tid_ >> 6);
    const GAS bf16* WE = (const GAS bf16*)(tab + T_WE); const GAS bf16* WX = (const GAS bf16*)(tab + T_WX); const float* ABL = (const float*)(tab + T_ABL);
    LAS unsigned char* Kc = lds + S_KC; LAS unsigned char* Us = lds + S_US; LAS float* Es = (LAS float*)(lds + S_ES); LAS unsigned char* Xs = lds + S_XS;
    __syncthreads();
    { const int tid = moba::opq(tid_);
      for (int i = tid; i < 16896 / 16; i += NTHREADS) *(LAS v4u*)(Kc + i * 16) = *(const GAS v4u*)(tab + T_KC + i * 16); }
    float sxr = 0.f, sxi = 0.f, alr = 0.f, ali = 0.f;
    if (w == 0) { const int lane = tid_ & 63; alr = ABL[lane]; ali = ABL[64 + lane]; }
    const GAS bf16* ub = (const GAS bf16*)UG + (size_t)(b * 32 + g) * SEQ * 16;
    for (int q = 0; q < 4; ++q) {
        __syncthreads();
        { const int tid = moba::opq(tid_);
#pragma unroll
          for (int i = 0; i < 8; ++i) { const int byte = (tid + 512 * i) * 16, row = byte >> 10, cb = byte & 1023;
              *(LAS v4u*)(Us + row * US_ROW + cb) = *(const GAS v4u*)((const GAS unsigned char*)ub + (size_t)q * 65536 + byte); } }
        __syncthreads();
        { const int lane = moba::opq(tid_) & 63, fr = lane & 15, kq = lane >> 4;
          f32x4 acc[4];
#pragma unroll
          for (int m = 0; m < 4; ++m) acc[m] = (f32x4){0.f, 0.f, 0.f, 0.f};
          const GAS bf16* wrow = WE + (size_t)(16 * w + fr) * 512 + 8 * kq;
#pragma unroll 4
          for (int ks = 0; ks < 16; ++ks) { const bf16x8 bfr = *(const GAS bf16x8*)(wrow + 32 * ks);
#pragma unroll
              for (int m = 0; m < 4; ++m) { const bf16x8 afr = *(const LAS bf16x8*)(Us + (16 * m + fr) * US_ROW + (32 * ks + 8 * kq) * 2); acc[m] = __builtin_amdgcn_mfma_f32_16x16x32_bf16(afr, bfr, acc[m], 0, 0, 0); } }
#pragma unroll
          for (int m = 0; m < 4; ++m)
#pragma unroll
              for (int r = 0; r < 4; ++r) Es[(16 * m + 4 * kq + r) * ES_ROW + 16 * w + fr] = acc[m][r]; }
        __syncthreads();
        if (w == 0) { const int lane = moba::opq(tid_) & 63;
#pragma unroll 8
            for (int j = 0; j < 64; ++j) { const float er = Es[j * ES_ROW + lane], ei = Es[j * ES_ROW + 64 + lane];
                *(LAS bf16*)(Xs + j * XS_ROW + lane * 2) = (bf16)f2bf(sxr); *(LAS bf16*)(Xs + j * XS_ROW + 128 + lane * 2) = (bf16)f2bf(sxi);
                const float nr = alr * sxr - ali * sxi + er, ni = alr * sxi + ali * sxr + ei; sxr = nr; sxi = ni; } }
        __syncthreads();
#pragma unroll 1
        for (int pass = 0; pass < 2; ++pass) {
            const int lane = moba::opq(tid_) & 63, fr = lane & 15, kq = lane >> 4;
            const int ta = pass == 0 ? w : 15 - w, tb = pass == 0 ? 31 - w : 16 + w;
            f32x4 aa[4], ab[4];
#pragma unroll
            for (int m = 0; m < 4; ++m) { aa[m] = (f32x4){0.f, 0.f, 0.f, 0.f}; ab[m] = (f32x4){0.f, 0.f, 0.f, 0.f}; }
            const LAS unsigned char* kcl = Kc + (fr * 16 + 8 * (kq & 1)) * 2;
            const int sh = kq >> 1;
#pragma unroll 1
            for (int ks = 0; ks <= (tb >> 1); ++ks) {
                bf16x8 afr[4];
#pragma unroll
                for (int m = 0; m < 4; ++m) afr[m] = *(const LAS bf16x8*)(Us + (16 * m + fr) * US_ROW + (32 * ks + 8 * kq) * 2);
                const bf16x8 bb = *(const LAS bf16x8*)(kcl + (tb - 2 * ks - sh + 1) * 512);
#pragma unroll
                for (int m = 0; m < 4; ++m) ab[m] = __builtin_amdgcn_mfma_f32_16x16x32_bf16(afr[m], bb, ab[m], 0, 0, 0);
                if (ks <= (ta >> 1)) { const bf16x8 ba = *(const LAS bf16x8*)(kcl + (ta - 2 * ks - sh + 1) * 512);
#pragma unroll
                    for (int m = 0; m < 4; ++m) aa[m] = __builtin_amdgcn_mfma_f32_16x16x32_bf16(afr[m], ba, aa[m], 0, 0, 0); }
            }
#pragma unroll
            for (int ks = 0; ks < 4; ++ks) {
                bf16x8 afr[4];
#pragma unroll
                for (int m = 0; m < 4; ++m) afr[m] = *(const LAS bf16x8*)(Xs + (16 * m + fr) * XS_ROW + (32 * ks + 8 * kq) * 2);
                const bf16x8 ba = *(const GAS bf16x8*)(WX + (size_t)(ta * 16 + fr) * 128 + 32 * ks + 8 * kq), bb = *(const GAS bf16x8*)(WX + (size_t)(tb * 16 + fr) * 128 + 32 * ks + 8 * kq);
#pragma unroll
                for (int m = 0; m < 4; ++m) { aa[m] = __builtin_amdgcn_mfma_f32_16x16x32_bf16(afr[m], ba, aa[m], 0, 0, 0); ab[m] = __builtin_amdgcn_mfma_f32_16x16x32_bf16(afr[m], bb, ab[m], 0, 0, 0); }
            }
            bf16* zb = Z + ((size_t)b * SEQ + (size_t)q * 2048) * 512 + g * 16 + fr;
#pragma unroll
            for (int m = 0; m < 4; ++m)
#pragma unroll
                for (int r = 0; r < 4; ++r) { const int ch = 16 * m + 4 * kq + r;
                    zb[(size_t)(ch * 32 + ta) * 512] = (bf16)f2bf(gelu_t(aa[m][r])); zb[(size_t)(ch * 32 + tb) * 512] = (bf16)f2bf(gelu_t(ab[m][r])); }
        }
    }
}
}
struct Frame {
    LAS unsigned char* lds;
    int tid, lane, wave, vcu, G;
    const float* in[24]; float* out; unsigned char* ws;
};
enum { I_X = 0, I_C, I_WADA, I_BADA, I_GPRE_MIX, I_GPOST_MIX, I_WIN, I_ARE, I_AIM, I_LOGDT, I_BRE, I_BIM, I_CRE, I_CIM, I_SD, I_WGLUA, I_WGLUB, I_WAO, I_WOUT, I_GPRE_FFN, I_GPOST_FFN, I_WGATE, I_WUP, I_WDOWN };

__device__ __forceinline__ void transpose_item(const float* W, int K, int N, bf16* WT, int k0, int n0, int drow0, LAS float* scr, int lane) {
#pragma unroll 8
    for (int i = 0; i < 32; ++i) { const int kk = 2 * i + (lane >> 5); scr[kk * 33 + (lane & 31)] = W[(size_t)(k0 + kk) * N + n0 + (lane & 31)]; }
    LDS_WAIT(); asm volatile("" ::: "memory");
    const int c = lane & 7;
#pragma unroll
    for (int j = 0; j < 4; ++j) { const int n = (lane >> 3) + 8 * j; const LAS float* s = scr + (8 * c) * 33 + n;
        v4u o; o.x = pk2(s[0 * 33], s[1 * 33]); o.y = pk2(s[2 * 33], s[3 * 33]); o.z = pk2(s[4 * 33], s[5 * 33]); o.w = pk2(s[6 * 33], s[7 * 33]);
        *(GAS v4u*)(WT + (size_t)(drow0 + n) * K + k0 + 8 * c) = o; }
    LDS_WAIT(); asm volatile("" ::: "memory");
}
__device__ __forceinline__ int ilv_row(int n0, int which) { return 256 * (n0 >> 7) + 128 * which + (n0 & 127); }

__device__ __forceinline__ void p0a_weights_mod(Frame& F) {
    LAS float* scr = (LAS float*)(F.lds + RING_OFF + F.wave * 16384);
    const int gw = F.vcu * NWAVES + F.wave, NGW = F.G * NWAVES;
    bf16* WIN = (bf16*)(F.ws + WS_WIN); bf16* WGLU = (bf16*)(F.ws + WS_WGLU); bf16* WAO = (bf16*)(F.ws + WS_WAO); bf16* WOUT = (bf16*)(F.ws + WS_WOUT); bf16* WGU = (bf16*)(F.ws + WS_WGU); bf16* WDN = (bf16*)(F.ws + WS_WDN);
    constexpr int I_IN = 16 * 128, I_GA = 8 * 32, I_AO = 8 * 32, I_OUT = 16 * 32, I_GT = 16 * 88, I_DN = 44 * 32;
    constexpr int NITEMS = I_IN + 2 * I_GA + I_AO + I_OUT + 2 * I_GT + I_DN;
    for (int it = gw; it < NITEMS; it += NGW) {
        int r = it;
        if (r < I_IN) { const int kb = r / 128, nb = r % 128; transpose_item(F.in[I_WIN], 1024, 4096, WIN, 64 * kb, 32 * nb, 32 * nb, scr, F.lane); continue; } r -= I_IN;
        if (r < I_GA) { const int kb = r / 32, nb = r % 32; transpose_item(F.in[I_WGLUA], 512, 1024, WGLU, 64 * kb, 32 * nb, ilv_row(32 * nb, 0), scr, F.lane); continue; } r -= I_GA;
        if (r < I_GA) { const int kb = r / 32, nb = r % 32; transpose_item(F.in[I_WGLUB], 512, 1024, WGLU, 64 * kb, 32 * nb, ilv_row(32 * nb, 1), scr, F.lane); continue; } r -= I_GA;
        if (r < I_AO) { const int kb = r / 32, nb = r % 32; transpose_item(F.in[I_WAO], 512, 1024, WAO, 64 * kb, 32 * nb, 32 * nb, scr, F.lane); continue; } r -= I_AO;
        if (r < I_OUT) { const int kb = r / 32, nb = r % 32; transpose_item(F.in[I_WOUT], 1024, 1024, WOUT, 64 * kb, 32 * nb, 32 * nb, scr, F.lane); continue; } r -= I_OUT;
        if (r < I_GT) { const int kb = r / 88, nb = r % 88; transpose_item(F.in[I_WGATE], 1024, 2816, WGU, 64 * kb, 32 * nb, ilv_row(32 * nb, 0), scr, F.lane); continue; } r -= I_GT;
        if (r < I_GT) { const int kb = r / 88, nb = r % 88; transpose_item(F.in[I_WUP], 1024, 2816, WGU, 64 * kb, 32 * nb, ilv_row(32 * nb, 1), scr, F.lane); continue; } r -= I_GT;
        { const int kb = r / 32, nb = r % 32; transpose_item(F.in[I_WDOWN], 2816, 1024, WDN, 64 * kb, 32 * nb, 32 * nb, scr, F.lane); }
    }
    __syncthreads();
    if (F.vcu < 96) {
        LAS float* cact = (LAS float*)(F.lds + RING_OFF);
        LAS float* red = cact + 4096;
        for (int i = F.tid; i < 4096; i += NTHREADS) { const float cv = F.in[I_C][i]; cact[i] = cv / (1.0f + __expf(-cv)); }
        __syncthreads();
        const float* wada = F.in[I_WADA]; float* mod = (float*)(F.ws + WS_MOD);
        for (int it = F.vcu; it < 96; it += F.G) {
            const int col = F.tid & 63, ks = F.tid >> 6, n = it * 64 + col;
            float a0 = 0.f, a1 = 0.f, a2 = 0.f, a3 = 0.f;
#pragma unroll 4
            for (int k = ks * 128; k < ks * 128 + 128; ++k) { const float w = wada[(size_t)k * 6144 + n]; a0 += cact[k] * w; a1 += cact[1024 + k] * w; a2 += cact[2048 + k] * w; a3 += cact[3072 + k] * w; }
            red[(ks * 4 + 0) * 64 + col] = a0; red[(ks * 4 + 1) * 64 + col] = a1; red[(ks * 4 + 2) * 64 + col] = a2; red[(ks * 4 + 3) * 64 + col] = a3;
            __syncthreads();
            if (F.tid < 256) { const int b = F.tid >> 6, c = F.tid & 63; float s = F.in[I_BADA][it * 64 + c];
#pragma unroll
                for (int q = 0; q < 8; ++q) s += red[(q * 4 + b) * 64 + c];
                mod[b * 6144 + it * 64 + c] = s; }
            __syncthreads();
        }
    } else if (F.vcu < 96 + NGRP) {
        const int g = F.vcu - 96;
        s5::ssm_tables(F.lds, F.tid, g, F.in[I_ARE], F.in[I_AIM], F.in[I_LOGDT], F.in[I_BRE], F.in[I_BIM], F.in[I_CRE], F.in[I_CIM], F.in[I_SD], F.ws + WS_SSMT + (size_t)g * s5::T_STRIDE);
    }
}

__device__ __forceinline__ void adaln_row(int lane, const float* xrow, const float* gw, const float* sc, const float* sh, bf16* orow) {
    const GAS f32x4* xr = (const GAS f32x4*)xrow + lane;
    f32x4 v[4]; float s = 0.f;
#pragma unroll
    for (int j = 0; j < 4; ++j) { v[j] = xr[64 * j]; s += (v[j].x * v[j].x + v[j].y * v[j].y) + (v[j].z * v[j].z + v[j].w * v[j].w); }
    const float rstd = 1.0f / sqrtf(wave_sum(s) * (1.0f / 1024.0f) + NORM_EPS);
    GAS unsigned long long* o8 = (GAS unsigned long long*)orow + lane;
#pragma unroll
    for (int j = 0; j < 4; ++j) { const f32x4 g4 = ((const GAS f32x4*)gw + lane)[64 * j], sc4 = ((const GAS f32x4*)sc + lane)[64 * j], sh4 = ((const GAS f32x4*)sh + lane)[64 * j];
        const f32x4 o = v[j] * rstd * g4 * (sc4 + 1.0f) + sh4;
        o8[64 * j] = (unsigned long long)pk2(o.x, o.y) | ((unsigned long long)pk2(o.z, o.w) << 32); }
}
__device__ __forceinline__ void p0b_hn(Frame& F) {
    const int gw = F.vcu * NWAVES + F.wave, NGW = F.G * NWAVES;
    const float* mod = (const float*)(F.ws + WS_MOD); bf16* HN = (bf16*)(F.ws + WS_HN);
    for (int m = gw; m < MT; m += NGW) { const int b = m >> 13;
        adaln_row(F.lane, F.in[I_X] + (size_t)m * 1024, F.in[I_GPRE_MIX], mod + b * 6144 + 1024, mod + b * 6144, HN + (size_t)m * 1024); }
}
__device__ __forceinline__ void norm_pass1(Frame& F) {
    const int gw = F.vcu * NWAVES + F.wave, NGW = F.G * NWAVES, lane = F.lane;
    const float* mod = (const float*)(F.ws + WS_MOD); bf16* HN2 = (bf16*)(F.ws + WS_HN); const float* Y = (const float*)(F.ws + WS_Y1);
    for (int m = gw; m < MT; m += NGW) { const int b = m >> 13;
        const GAS f32x4* yr = (const GAS f32x4*)(Y + (size_t)m * 1024) + lane; const GAS f32x4* xr = (const GAS f32x4*)(F.in[I_X] + (size_t)m * 1024) + lane;
        f32x4 y[4], x1[4]; float s = 0.f;
#pragma unroll
        for (int j = 0; j < 4; ++j) { y[j] = yr[64 * j]; s += (y[j].x * y[j].x + y[j].y * y[j].y) + (y[j].z * y[j].z + y[j].w * y[j].w); }
        const float rstd = 1.0f / sqrtf(wave_sum(s) * (1.0f / 1024.0f) + NORM_EPS); float s2 = 0.f;
#pragma unroll
        for (int j = 0; j < 4; ++j) { const f32x4 g4 = ((const GAS f32x4*)F.in[I_GPOST_MIX] + lane)[64 * j], gt4 = ((const GAS f32x4*)(mod + b * 6144 + 2048) + lane)[64 * j];
            x1[j] = xr[64 * j] + gt4 * (y[j] * rstd * g4); ((GAS f32x4*)(F.out + (size_t)m * 1024) + lane)[64 * j] = x1[j];
            s2 += (x1[j].x * x1[j].x + x1[j].y * x1[j].y) + (x1[j].z * x1[j].z + x1[j].w * x1[j].w); }
        const float rstd2 = 1.0f / sqrtf(wave_sum(s2) * (1.0f / 1024.0f) + NORM_EPS);
        GAS unsigned long long* o8 = (GAS unsigned long long*)(HN2 + (size_t)m * 1024) + lane;
#pragma unroll
        for (int j = 0; j < 4; ++j) { const f32x4 g4 = ((const GAS f32x4*)F.in[I_GPRE_FFN] + lane)[64 * j], sc4 = ((const GAS f32x4*)(mod + b * 6144 + 4096) + lane)[64 * j], sh4 = ((const GAS f32x4*)(mod + b * 6144 + 3072) + lane)[64 * j];
            const f32x4 o = x1[j] * rstd2 * g4 * (sc4 + 1.0f) + sh4;
            o8[64 * j] = (unsigned long long)pk2(o.x, o.y) | ((unsigned long long)pk2(o.z, o.w) << 32); }
    }
}
__device__ __forceinline__ void norm_pass2(Frame& F) {
    const int gw = F.vcu * NWAVES + F.wave, NGW = F.G * NWAVES, lane = F.lane;
    const float* mod = (const float*)(F.ws + WS_MOD); const float* Y = (const float*)(F.ws + WS_Y2);
    for (int m = gw; m < MT; m += NGW) { const int b = m >> 13;
        const GAS f32x4* yr = (const GAS f32x4*)(Y + (size_t)m * 1024) + lane; GAS f32x4* xr = (GAS f32x4*)(F.out + (size_t)m * 1024) + lane;
        f32x4 y[4]; float s = 0.f;
#pragma unroll
        for (int j = 0; j < 4; ++j) { y[j] = yr[64 * j]; s += (y[j].x * y[j].x + y[j].y * y[j].y) + (y[j].z * y[j].z + y[j].w * y[j].w); }
        const float rstd = 1.0f / sqrtf(wave_sum(s) * (1.0f / 1024.0f) + NORM_EPS);
#pragma unroll
        for (int j = 0; j < 4; ++j) { const f32x4 g4 = ((const GAS f32x4*)F.in[I_GPOST_FFN] + lane)[64 * j], gt4 = ((const GAS f32x4*)(mod + b * 6144 + 5120) + lane)[64 * j];
            xr[64 * j] = xr[64 * j] + gt4 * (y[j] * rstd * g4); }
    }
}

__device__ __forceinline__ void kmean_phase(Frame& F) {
    const int gw = F.vcu * NWAVES + F.wave, NGW = F.G * NWAVES;
    const bf16* KH = (const bf16*)(F.ws + WS_KH); float* KM = (float*)(F.ws + WS_KMEAN);
    for (int u = gw; u < NB * NH * NBLK; u += NGW) {
        const bf16* kp = KH + (size_t)u * MBLK * 64 + F.lane; float s = 0.f;
#pragma unroll 8
        for (int k = 0; k < MBLK; ++k) s += bf2f(kp[k * 64]);
        KM[u * 64 + F.lane] = s * (1.0f / 256.0f);
    }
}

__device__ __forceinline__ float gelu_tanh(float y) {
    const float a = 0.7978845608028654f * (y + 0.044715f * y * y * y);
    const float e = __builtin_amdgcn_exp2f(2.0f * LOG2E * a);
    const float t = 1.0f - 2.0f * __builtin_amdgcn_rcpf(e + 1.0f);
    return 0.5f * y * (1.0f + t);
}
__device__ __forceinline__ void ssm_simple_phase(Frame& F) {
    const int gw = F.vcu * NWAVES + F.wave, NGW = F.G * NWAVES, lane = F.lane;
    LAS float* Cl = (LAS float*)(F.lds + RING_OFF + F.wave * 16384);
    LAS float* xs = Cl + 16 * 132;
    LAS float* us = xs + 4 * 132;
    const bf16* UG = (const bf16*)(F.ws + WS_UG); bf16* Z = (bf16*)(F.ws + WS_Z);
    for (int unit = gw; unit < NB * NGRP; unit += NGW) {
        const int b = unit >> 5, g = unit & 31, p = lane;
        const float dt = expf(F.in[I_LOGDT][g]), are = F.in[I_ARE][g * 64 + p], aim = F.in[I_AIM][g * 64 + p];
        const float mag = expf(dt * are), abr = mag * cosf(dt * aim), abi = mag * sinf(dt * aim);
        const float den = are * are + aim * aim, nr = abr - 1.0f, cor = (nr * are + abi * aim) / den, coi = (abi * are - nr * aim) / den;
        float bbr[16], bbi[16];
#pragma unroll
        for (int c = 0; c < 16; ++c) { const float br = F.in[I_BRE][(g * 64 + p) * 16 + c], bi = F.in[I_BIM][(g * 64 + p) * 16 + c]; bbr[c] = cor * br - coi * bi; bbi[c] = cor * bi + coi * br; }
#pragma unroll
        for (int c = 0; c < 16; ++c) { Cl[c * 132 + p] = F.in[I_CRE][(g * 16 + c) * 64 + p]; Cl[c * 132 + 64 + p] = -F.in[I_CIM][(g * 16 + c) * 64 + p]; }
        const float dsk = F.in[I_SD][g * 16 + (lane & 15)];
        float xr = 0.f, xi = 0.f;
        const bf16* up = UG + (size_t)(b * 32 + g) * SEQ * 16;
        const int tt = lane >> 4, c = lane & 15;
        for (int t0 = 0; t0 < SEQ; t0 += 4) {
            const float uf = bf2f(up[(size_t)t0 * 16 + lane]);
            us[lane] = uf;
            asm volatile("s_waitcnt lgkmcnt(0)" ::: "memory");
#pragma unroll
            for (int q = 0; q < 4; ++q) {
                float bur = 0.f, bui = 0.f;
#pragma unroll
                for (int cc = 0; cc < 16; ++cc) { const float uv = us[q * 16 + cc]; bur += bbr[cc] * uv; bui += bbi[cc] * uv; }
                const float nxr = abr * xr - abi * xi + bur, nxi = abr * xi + abi * xr + bui; xr = nxr; xi = nxi;
                xs[q * 132 + p] = xr; xs[q * 132 + 64 + p] = xi;
            }
            asm volatile("s_waitcnt lgkmcnt(0)" ::: "memory");
            float y = 0.f;
#pragma unroll 8
            for (int q = 0; q < 128; q += 4) { const f32x4 cv = *(const LAS f32x4*)(Cl + c * 132 + q), xv = *(const LAS f32x4*)(xs + tt * 132 + q); y += (cv.x * xv.x + cv.y * xv.y) + (cv.z * xv.z + cv.w * xv.w); }
            y += dsk * uf;
            Z[(size_t)(b * SEQ + t0 + tt) * 512 + g * 16 + c] = (bf16)f2bf(gelu_tanh(y));
            asm volatile("s_waitcnt lgkmcnt(0)" ::: "memory");
        }
    }
}

__device__ __forceinline__ void attn_simple_phase(Frame& F) {
    const int gw = F.vcu * NWAVES + F.wave, NGW = F.G * NWAVES, lane = F.lane;
    LAS float* qs = (LAS float*)(F.lds + RING_OFF + F.wave * 8192);
    LAS float* lg = qs + 64;
    const bf16* QH = (const bf16*)(F.ws + WS_QH); const bf16* KH = (const bf16*)(F.ws + WS_KH); const bf16* VH = (const bf16*)(F.ws + WS_VH);
    const float* KM = (const float*)(F.ws + WS_KMEAN); bf16* O = (bf16*)(F.ws + WS_O);
    const float NEG = -INFINITY;
    for (int unit = gw; unit < NB * NH * SEQ; unit += NGW) {
        const int t = unit & 8191, bh = unit >> 13, h = bh & 7, b = bh >> 3, qb = t >> 8;
        const float sl2 = exp2f(-(float)(h + 1)) * LOG2E;
        qs[lane] = bf2f(QH[((size_t)bh * SEQ + t) * 64 + lane]);
        asm volatile("s_waitcnt lgkmcnt(0)" ::: "memory");
        float gv = NEG;
        if (lane < qb) { const float* km = KM + ((size_t)bh * 32 + lane) * 64; float s = 0.f;
#pragma unroll 8
            for (int d = 0; d < 64; ++d) s += qs[d] * km[d];
            gv = s; }
        const int nsel = qb < 3 ? qb : 3; int sel0 = 0, sel1 = 0, sel2 = 0;
#pragma unroll
        for (int k = 0; k < 3; ++k) if (k < nsel) {
            const float m = wave_max(gv); const unsigned long long mask = __ballot(gv == m); const int idx = __ffsll((long long)mask) - 1;
            if (k == 0) sel0 = idx; else if (k == 1) sel1 = idx; else sel2 = idx;
            if (lane == idx) gv = NEG; }
        const int nown = t - qb * 256 + 1, nkeys = nsel * 256 + nown;
        const bf16* Kb = KH + (size_t)bh * SEQ * 64; const bf16* Vb = VH + (size_t)bh * SEQ * 64;
        float mx = NEG;
        for (int i = 0; i * 64 < nkeys; ++i) {
            const int kk = i * 64 + lane; const bool valid = kk < nkeys; const int seg = kk >> 8;
            const int blk = (seg < nsel) ? (seg == 0 ? sel0 : (seg == 1 ? sel1 : sel2)) : qb;
            const int pos = valid ? blk * 256 + (kk & 255) : t;
            const GAS v4u* kr = (const GAS v4u*)(Kb + (size_t)pos * 64); float dot = 0.f;
#pragma unroll
            for (int j = 0; j < 8; ++j) { const v4u w = kr[j];
                dot += qs[8 * j + 0] * __uint_as_float(w.x << 16) + qs[8 * j + 1] * __uint_as_float(w.x & 0xffff0000u) + qs[8 * j + 2] * __uint_as_float(w.y << 16) + qs[8 * j + 3] * __uint_as_float(w.y & 0xffff0000u)
                     + qs[8 * j + 4] * __uint_as_float(w.z << 16) + qs[8 * j + 5] * __uint_as_float(w.z & 0xffff0000u) + qs[8 * j + 6] * __uint_as_float(w.w << 16) + qs[8 * j + 7] * __uint_as_float(w.w & 0xffff0000u); }
            const float l = valid ? dot - sl2 * (float)(t - pos) : NEG;
            lg[kk] = l; mx = fmaxf(mx, l);
        }
        mx = wave_max(mx);
        asm volatile("s_waitcnt lgkmcnt(0)" ::: "memory");
        float sum = 0.f;
        for (int i = 0; i * 64 < nkeys; ++i) { const int kk = i * 64 + lane; const float pv = __builtin_amdgcn_exp2f(lg[kk] - mx); lg[kk] = pv; sum += pv; }
        sum = wave_sum(sum);
        asm volatile("s_waitcnt lgkmcnt(0)" ::: "memory");
        float o = 0.f;
        for (int seg = 0; seg <= nsel; ++seg) {
            const int blk = (seg < nsel) ? (seg == 0 ? sel0 : (seg == 1 ? sel1 : sel2)) : qb; const int cnt = (seg < nsel) ? 256 : nown;
            const bf16* vp = Vb + (size_t)blk * 256 * 64 + lane; const LAS float* pp = lg + seg * 256;
#pragma unroll 4
            for (int k = 0; k < cnt; ++k) o += pp[k] * bf2f(vp[(size_t)k * 64]);
        }
        O[((size_t)(b * SEQ + t)) * 512 + h * 64 + lane] = (bf16)f2bf(o / sum);
        asm volatile("s_waitcnt lgkmcnt(0)" ::: "memory");
    }
}

struct Args { const float* in[24]; float* out; unsigned char* ws; int ph_lo, ph_hi; };
constexpr int N_PHASES = 12;
__global__ void __launch_bounds__(NTHREADS, 2) mk_fwd(Args args) {
    extern __shared__ __attribute__((aligned(16))) unsigned char lds[];
    Frame F;
    F.lds = (LAS unsigned char*)lds;
    F.tid = threadIdx.x; F.lane = F.tid & 63; F.wave = __builtin_amdgcn_readfirstlane(F.tid >> 6);
    F.G = gridDim.x; { const int bx = blockIdx.x; F.vcu = (F.G % 8 == 0) ? (bx % 8) * (F.G / 8) + bx / 8 : bx; }
#pragma unroll
    for (int i = 0; i < 24; ++i) F.in[i] = args.in[i];
    F.out = args.out; F.ws = args.ws;
    unsigned char* ws = args.ws;
    const int lo = args.ph_lo, hi = args.ph_hi;
    for (int u = F.tid; u < (LDS_BYTES - LDSCTL_OFF) / 4; u += NTHREADS) ((LAS unsigned*)(F.lds + LDSCTL_OFF))[u] = 0u;
    __syncthreads();
    XcdBarrier bar = xcd_barrier_post((unsigned*)(ws + WS_CTL) + CW_BAR, (volatile LAS unsigned*)(F.lds + MISC_OFF) + 8);
#define GRID_BAR(k) do { if (IN(k) && IN((k) + 1)) xcd_barrier(bar); } while (0)
#define IN(k) (lo <= (k) && (k) < hi)
    if (IN(0)) { p0a_weights_mod(F); }
    GRID_BAR(0);
    if (IN(1)) { p0b_hn(F); }
    GRID_BAR(1);
    if (IN(2)) {
        pg8::Gemm g{(const bf16*)(ws + WS_HN), (const bf16*)(ws + WS_WIN), MT, INW, DM}; pg8::StaticOrder S; S.init(MT, INW, F.G, (int)blockIdx.x);
        pg8::EpiProj E{(bf16*)(ws + WS_UG), (bf16*)(ws + WS_QH), (bf16*)(ws + WS_G), (size_t)(WS_KH - WS_QH) / 2, QSCALE};
        static_assert(WS_VH - WS_KH == WS_KH - WS_QH, "q|k|v equally spaced");
        pg8::gemm_phase<pg8::EpiProj, pg8::StaticOrder, true, true>(F.lds + RING_OFF, g, S, E);
    }
    GRID_BAR(2);
    if (IN(3)) { moba::kmean_vt_phase(F.lds, F.tid, F.vcu, F.G, (const bf16*)(ws + WS_KH), (const bf16*)(ws + WS_VH), (float*)(ws + WS_KMEAN), (bf16*)(ws + WS_VT));
        for (int u = F.vcu; u < NB * NGRP; u += F.G) s5::ssm_unit(F.lds, F.tid, u >> 5, u & 31, (const bf16*)(ws + WS_UG), ws + WS_SSMT + (size_t)(u & 31) * s5::T_STRIDE, (bf16*)(ws + WS_Z)); }
    GRID_BAR(3);
    if (IN(4)) { moba::attn_phase(F.lds, F.tid, F.vcu, F.G, (const bf16*)(ws + WS_QH), (const bf16*)(ws + WS_KH), (const bf16*)(ws + WS_VT), (const float*)(ws + WS_KMEAN), (bf16*)(ws + WS_O)); }
    GRID_BAR(4);
    if (IN(5)) {
        pg8::Gemm g{(const bf16*)(ws + WS_Z), (const bf16*)(ws + WS_WGLU), MT, 2048, 512}; pg8::StaticOrder S; S.init(MT, 2048, F.G, (int)blockIdx.x);
        pg8::EpiGlu E{(const bf16*)(ws + WS_G), (bf16*)(ws + WS_T1)};
        pg8::gemm_phase<pg8::EpiGlu, pg8::StaticOrder, true, true>(F.lds + RING_OFF, g, S, E);
    }
    GRID_BAR(5);
    if (IN(6)) {
        pg8::Gemm g{(const bf16*)(ws + WS_O), (const bf16*)(ws + WS_WAO), MT, 1024, 512}; pg8::StaticOrder S; S.init(MT, 1024, F.G, (int)blockIdx.x);
        pg8::EpiMerge E{(const bf16*)(ws + WS_G), (const bf16*)(ws + WS_T1), (bf16*)(ws + WS_MG)};
        pg8::gemm_phase<pg8::EpiMerge, pg8::StaticOrder, true, true>(F.lds + RING_OFF, g, S, E);
    }
    GRID_BAR(6);
    if (IN(7)) {
        pg8::Gemm g{(const bf16*)(ws + WS_MG), (const bf16*)(ws + WS_WOUT), MT, 1024, 1024}; pg8::StaticOrder S; S.init(MT, 1024, F.G, (int)blockIdx.x);
        pg8::EpiF32 E{(float*)(ws + WS_Y1), 1024};
        pg8::gemm_phase<pg8::EpiF32, pg8::StaticOrder, true, true>(F.lds + RING_OFF, g, S, E);
    }
    GRID_BAR(7);
    if (IN(8)) { norm_pass1(F); }
    GRID_BAR(8);
    if (IN(9)) {
        pg8::Gemm g{(const bf16*)(ws + WS_HN), (const bf16*)(ws + WS_WGU), MT, 2 * FF, 1024}; pg8::StaticOrder S; S.init(MT, 2 * FF, F.G, (int)blockIdx.x);
        pg8::EpiSwiGlu E{(bf16*)(ws + WS_H)};
        pg8::gemm_phase<pg8::EpiSwiGlu, pg8::StaticOrder, true, true>(F.lds + RING_OFF, g, S, E);
    }
    GRID_BAR(9);
    if (IN(10)) {
        pg8::Gemm g{(const bf16*)(ws + WS_H), (const bf16*)(ws + WS_WDN), MT, 1024, FF}; pg8::StaticOrder S; S.init(MT, 1024, F.G, (int)blockIdx.x);
        pg8::EpiF32 E{(float*)(ws + WS_Y2), 1024};
        pg8::gemm_phase<pg8::EpiF32, pg8::StaticOrder, true, true>(F.lds + RING_OFF, g, S, E);
    }
    GRID_BAR(10);
    if (IN(11)) { norm_pass2(F); }
#undef IN
#undef GRID_BAR
}

extern "C" void kernel_launch(void* const* d_in, const int* in_sizes, int n_in, void* d_out, int out_size, void* d_ws, size_t ws_size, hipStream_t stream) {
    static int grid = 0;
    if (grid == 0) {
        if (n_in != 24 || in_sizes[0] != MT * DM || out_size != MT * DM || ws_size < WS_END) { fprintf(stderr, "kernel_launch: unexpected shapes (n_in %d, in0 %d, out %d, ws %zu); nothing launched\n", n_in, n_in > 0 ? in_sizes[0] : -1, out_size, ws_size); grid = -1; return; }
        int dev = 0, cus = 0;
        if (hipGetDevice(&dev) != hipSuccess || hipDeviceGetAttribute(&cus, hipDeviceAttributeMultiprocessorCount, dev) != hipSuccess) { grid = -1; return; }
        if (hipFuncSetAttribute((const void*)mk_fwd, hipFuncAttributeMaxDynamicSharedMemorySize, LDS_BYTES) != hipSuccess) { fprintf(stderr, "kernel_launch: hipFuncSetAttribute failed\n"); grid = -1; return; }
        (void)hipGetLastError();
        grid = cus;
    }
    if (grid < 0) return;
    (void)hipMemsetAsync((char*)d_ws + WS_CTL, 0, CTL_ZERO_BYTES, stream);
    Args a{};
    for (int i = 0; i < 24; ++i) a.in[i] = (const float*)d_in[i];
    a.out = (float*)d_out; a.ws = (unsigned char*)d_ws;
    a.ph_lo = 0; a.ph_hi = N_PHASES;
    hipLaunchKernelGGL(mk_fwd, dim3(grid), dim3(NTHREADS), LDS_BYTES, stream, a);
}
```
